# Optimizing an MI355X kernel written in HIP

```python
import math
import jax, jax.numpy as jnp
from jax import lax
import numpy as np

D_MODEL = 1024
BATCH = 2
SEQ = 8192
DEPTH = 1

GRID_W = 64
CTX_LEN = 256
N_DA_HEADS = 4
DA_HEAD_DIM = 64
DA_V_DIM = 2 * DA_HEAD_DIM
QK_WIDTH = N_DA_HEADS * 2 * DA_HEAD_DIM
ATTN_WIDTH = N_DA_HEADS * DA_V_DIM
N_FOURIER_GROUPS = 4
FOURIER_GROUP_DIM = 128
FOURIER_WIDTH = N_FOURIER_GROUPS * FOURIER_GROUP_DIM
MIX_WIDTH = ATTN_WIDTH + FOURIER_WIDTH
IN_PROJ_WIDTH = 2 * QK_WIDTH + ATTN_WIDTH + FOURIER_WIDTH
ROPE_THETA = 10000.0
ROPE_AXIS_DIM = DA_HEAD_DIM // 2
Q_BLOCK = 128
N_GROUPS = 4
EXPERTS_PER_GROUP = 8
N_EXPERTS = N_GROUPS * EXPERTS_PER_GROUP
TOP_K = 2
D_EXPERT = 512
MOE_BLOCK = 128
N_MOD = 6
EPS = 1e-6

kernel_name = 'hybrid_diffattn_fnet_hmoe_dit_block'


def rms_norm(x, g):
    xf = x.astype(jnp.float32)
    y = xf * lax.rsqrt(jnp.mean(xf * xf, axis=-1, keepdims=True) + EPS)
    return (y * g.astype(jnp.float32)).astype(x.dtype)


def modulate(h, shift, scale):
    return h * (1 + scale) + shift


def axial_rope_tables(rows, dtype):
    r, col = jnp.meshgrid(jnp.arange(rows), jnp.arange(GRID_W), indexing='ij')
    pos = jnp.stack([r.reshape(-1), col.reshape(-1)], axis=-1).astype(jnp.float32)
    inv_freq = ROPE_THETA ** (-jnp.arange(0, ROPE_AXIS_DIM, 2, dtype=jnp.float32) / ROPE_AXIS_DIM)
    ang = pos[:, :, None] * inv_freq
    ang = jnp.concatenate([ang, ang], axis=-1)
    return jnp.cos(ang).astype(dtype), jnp.sin(ang).astype(dtype)


def apply_axial_rope(x, cos, sin):
    xr = x.reshape(*x.shape[:-1], 2, ROPE_AXIS_DIM)
    x1, x2 = jnp.split(xr, 2, axis=-1)
    rot = jnp.concatenate([-x2, x1], axis=-1)
    c = cos[None, :, None, None]
    s = sin[None, :, None, None]
    return (xr * c + rot * s).reshape(x.shape)


def diff_lambda(lq1, lk1, lq2, lk2, lambda_init):
    f = lambda a: a.astype(jnp.float32)
    return jnp.exp(jnp.sum(f(lq1) * f(lk1))) - jnp.exp(jnp.sum(f(lq2) * f(lk2))) + lambda_init


def diff_attention(q, k, v, lam, g_subln, lambda_init):
    b, n = q.shape[:2]
    nb = n // Q_BLOCK
    qb = jnp.moveaxis(q.reshape(b, nb, Q_BLOCK, *q.shape[2:]), 1, 0)
    scale = DA_HEAD_DIM ** -0.5

    def block(qi):
        s = jnp.einsum('bqhmd,bkhmd->bhmqk', qi, k, preferred_element_type=jnp.float32) * scale
        p = jax.nn.softmax(s, axis=-1)
        a = p[:, :, 0] - lam * p[:, :, 1]
        return jnp.einsum('bhqk,bkhv->bqhv', a.astype(v.dtype), v)

    o = lax.map(block, qb)
    o = jnp.moveaxis(o, 0, 1).reshape(b, n, N_DA_HEADS, DA_V_DIM)
    o = rms_norm(o, g_subln) * (1.0 - lambda_init)
    return o.reshape(b, n, ATTN_WIDTH)


def fourier_mix(f, w_fourier):
    b, n, _ = f.shape
    fg = f.reshape(b, n, N_FOURIER_GROUPS, FOURIER_GROUP_DIM).astype(jnp.float32)
    fr = jnp.fft.fft2(fg, axes=(1, 3), norm='ortho').real.astype(f.dtype)
    return jnp.einsum('bngc,gcd->bngd', fr, w_fourier).reshape(b, n, FOURIER_WIDTH)


def hier_moe(h, w_rg, b_rg, w_re, b_re, w_gate, w_up, w_down):
    t, d = h.shape
    hf = h.astype(jnp.float32)
    g_logits = hf @ w_rg.astype(jnp.float32) + b_rg.astype(jnp.float32)
    grp = jnp.argmax(g_logits, axis=-1)
    p_grp = jnp.take_along_axis(jax.nn.softmax(g_logits, axis=-1), grp[:, None], axis=-1)
    e_logits = (hf @ w_re.astype(jnp.float32) + b_re.astype(jnp.float32)).reshape(t, N_GROUPS, EXPERTS_PER_GROUP)
    e_in = jnp.take_along_axis(e_logits, grp[:, None, None], axis=1)[:, 0]
    top_val, top_idx = lax.top_k(e_in, TOP_K)
    gate = p_grp * jax.nn.softmax(top_val, axis=-1)
    expert = grp[:, None] * EXPERTS_PER_GROUP + top_idx

    n_assign = t * TOP_K
    e_flat = expert.reshape(n_assign).astype(jnp.int32)
    tok_flat = jnp.repeat(jnp.arange(t, dtype=jnp.int32), TOP_K)
    w_flat = gate.reshape(n_assign)
    order = jnp.argsort(e_flat)
    e_sorted = e_flat[order]
    counts = jnp.bincount(e_flat, length=N_EXPERTS).astype(jnp.int32)
    starts = jnp.cumsum(counts) - counts
    padded = (counts + MOE_BLOCK - 1) // MOE_BLOCK * MOE_BLOCK
    pad_ends = jnp.cumsum(padded)
    pad_starts = pad_ends - padded
    dest = pad_starts[e_sorted] + jnp.arange(n_assign, dtype=jnp.int32) - starts[e_sorted]
    n_blocks = -(-n_assign // MOE_BLOCK) + N_EXPERTS
    buf_tok = jnp.full((n_blocks * MOE_BLOCK,), t, jnp.int32).at[dest].set(tok_flat[order])
    buf_w = jnp.zeros((n_blocks * MOE_BLOCK,), h.dtype).at[dest].set(w_flat[order].astype(h.dtype))
    block_expert = jnp.minimum(
        jnp.searchsorted(pad_ends, jnp.arange(n_blocks, dtype=jnp.int32) * MOE_BLOCK, side='right'),
        N_EXPERTS - 1)
    h_pad = jnp.concatenate([h, jnp.zeros((1, d), h.dtype)], axis=0)

    def expert_block(args):
        tok, wt, e = args
        xb = h_pad[tok]
        y = (jax.nn.silu(xb @ w_gate[e]) * (xb @ w_up[e])) @ w_down[e]
        return y * wt[:, None]

    ys = lax.map(expert_block, (buf_tok.reshape(n_blocks, MOE_BLOCK),
                                buf_w.reshape(n_blocks, MOE_BLOCK), block_expert))
    out = jnp.zeros((t + 1, d), ys.dtype).at[buf_tok].add(ys.reshape(-1, d))
    return out[:t]


def setup_inputs(seed: int = 0) -> dict:
    key = jax.random.key(seed)
    ks = jax.random.split(key, 24)
    f32 = jnp.float32
    nrm = lambda k, shape, std: jax.random.normal(k, shape, f32) * std
    L = DEPTH
    return {
        'x': nrm(ks[0], (BATCH, SEQ, D_MODEL), 1.0),
        'c': nrm(ks[1], (BATCH, D_MODEL), 1.0),
        'ctx': nrm(ks[2], (BATCH, CTX_LEN, D_MODEL), 1.0),
        'c_ctx': nrm(ks[3], (D_MODEL,), 1.0),
        'w_ada': nrm(ks[4], (L, D_MODEL, N_MOD * D_MODEL), 0.5 * D_MODEL ** -0.5),
        'b_ada': nrm(ks[5], (L, N_MOD * D_MODEL), 0.02),
        'g_mix_norm': 1.0 + nrm(ks[6], (L, D_MODEL), 0.02),
        'g_ffn_norm': 1.0 + nrm(ks[7], (L, D_MODEL), 0.02),
        'w_in': nrm(ks[8], (L, D_MODEL, IN_PROJ_WIDTH), D_MODEL ** -0.5),
        'lambda_q1': nrm(ks[9], (L, DA_HEAD_DIM), 0.1),
        'lambda_k1': nrm(ks[10], (L, DA_HEAD_DIM), 0.1),
        'lambda_q2': nrm(ks[11], (L, DA_HEAD_DIM), 0.1),
        'lambda_k2': nrm(ks[12], (L, DA_HEAD_DIM), 0.1),
        'g_subln': 1.0 + nrm(ks[13], (L, DA_V_DIM), 0.02),
        'w_fourier': nrm(ks[14], (L, N_FOURIER_GROUPS, FOURIER_GROUP_DIM, FOURIER_GROUP_DIM), FOURIER_GROUP_DIM ** -0.5),
        'w_out': nrm(ks[15], (L, MIX_WIDTH, D_MODEL), MIX_WIDTH ** -0.5),
        'w_router_group': nrm(ks[16], (L, D_MODEL, N_GROUPS), D_MODEL ** -0.5),
        'b_router_group': nrm(ks[17], (L, N_GROUPS), 0.01),
        'w_router_expert': nrm(ks[18], (L, D_MODEL, N_EXPERTS), D_MODEL ** -0.5),
        'b_router_expert': nrm(ks[19], (L, N_EXPERTS), 0.01),
        'w_gate': nrm(ks[20], (L, N_EXPERTS, D_MODEL, D_EXPERT), D_MODEL ** -0.5),
        'w_up': nrm(ks[21], (L, N_EXPERTS, D_MODEL, D_EXPERT), D_MODEL ** -0.5),
        'w_down': nrm(ks[22], (L, N_EXPERTS, D_EXPERT, D_MODEL), D_EXPERT ** -0.5),
        'g_final': 1.0 + nrm(ks[23], (D_MODEL,), 0.02),
    }


def reference(x, c, ctx, c_ctx, w_ada, b_ada, g_mix_norm, g_ffn_norm, w_in,
              lambda_q1, lambda_k1, lambda_q2, lambda_k2, g_subln, w_fourier, w_out,
              w_router_group, b_router_group, w_router_expert, b_router_expert,
              w_gate, w_up, w_down, g_final):
    b, s, d = x.shape
    n_ctx = ctx.shape[1]
    ROWS = s // GRID_W
    cos, sin = axial_rope_tables(ROWS, x.dtype)
    o_k = QK_WIDTH
    o_v = 2 * QK_WIDTH
    o_f = 2 * QK_WIDTH + ATTN_WIDTH
    xl, xc = x, ctx
    for l in range(DEPTH):
        last = l == DEPTH - 1
        lambda_init = 0.8 - 0.6 * math.exp(-0.3 * l)
        lam = diff_lambda(lambda_q1[l], lambda_k1[l], lambda_q2[l], lambda_k2[l], lambda_init)
        mod_l = (jax.nn.silu(c) @ w_ada[l] + b_ada[l]).reshape(b, N_MOD, 1, d)
        mod_c = (jax.nn.silu(c_ctx) @ w_ada[l] + b_ada[l]).reshape(N_MOD, d)
        sh1, sc1, gt1, sh2, sc2, gt2 = (mod_l[:, i] for i in range(N_MOD))
        csh1, csc1, cgt1, csh2, csc2, cgt2 = (mod_c[i] for i in range(N_MOD))
        wl = w_in[l]
        moe_args = (w_router_group[l], b_router_group[l], w_router_expert[l], b_router_expert[l],
                    w_gate[l], w_up[l], w_down[l])

        hl = modulate(rms_norm(xl, g_mix_norm[l]), sh1, sc1)
        pl = hl @ wl
        ql = apply_axial_rope(pl[..., :o_k].reshape(b, s, N_DA_HEADS, 2, DA_HEAD_DIM), cos, sin)
        kl = apply_axial_rope(pl[..., o_k:o_v].reshape(b, s, N_DA_HEADS, 2, DA_HEAD_DIM), cos, sin)
        vl = pl[..., o_v:o_f].reshape(b, s, N_DA_HEADS, DA_V_DIM)
        fl = pl[..., o_f:]

        hc = modulate(rms_norm(xc, g_mix_norm[l]), csh1, csc1)
        pc_kv = hc @ wl[:, o_k:o_f]
        kc = pc_kv[..., :QK_WIDTH].reshape(b, n_ctx, N_DA_HEADS, 2, DA_HEAD_DIM)
        vc = pc_kv[..., QK_WIDTH:].reshape(b, n_ctx, N_DA_HEADS, DA_V_DIM)

        k_all = jnp.concatenate([kc, kl], axis=1)
        v_all = jnp.concatenate([vc, vl], axis=1)
        mix_l = jnp.concatenate([diff_attention(ql, k_all, v_all, lam, g_subln[l], lambda_init),
                                 fourier_mix(fl, w_fourier[l])], axis=-1)
        xl = xl + gt1 * (mix_l @ w_out[l])
        h2l = modulate(rms_norm(xl, g_ffn_norm[l]), sh2, sc2)

        if last:
            xl = xl + gt2 * hier_moe(h2l.reshape(b * s, d), *moe_args).reshape(b, s, d)
        else:
            qc = (hc @ wl[:, :o_k]).reshape(b, n_ctx, N_DA_HEADS, 2, DA_HEAD_DIM)
            fc = hc @ wl[:, o_f:]
            mix_c = jnp.concatenate([diff_attention(qc, kc, vc, lam, g_subln[l], lambda_init),
                                     fourier_mix(fc, w_fourier[l])], axis=-1)
            xc = xc + cgt1 * (mix_c @ w_out[l])
            h2c = modulate(rms_norm(xc, g_ffn_norm[l]), csh2, csc2)
            y = hier_moe(jnp.concatenate([h2l.reshape(b * s, d), h2c.reshape(b * n_ctx, d)], axis=0), *moe_args)
            xl = xl + gt2 * y[:b * s].reshape(b, s, d)
            xc = xc + cgt2 * y[b * s:].reshape(b, n_ctx, d)
    return rms_norm(xl, g_final)
```

```cpp
#include <hip/hip_runtime.h>
#include <cstdint>
#include <cstdio>

typedef unsigned short bf16;
constexpr int NB = 2, S = 8192, D = 1024, M = NB * S, CTX = 256, KV = CTX + S, NH = 4, NEXP = 32, DE = 512;
constexpr int KO = 1536;
constexpr float EPS = 1e-6f;
constexpr float C2 = 0.125f * 1.4426950408889634f;
constexpr int MAXSLOT = 40960;

constexpr size_t MiB = 1u << 20;
constexpr size_t WS_CTL = 0, CTL_ZERO_BYTES = 1 * MiB;
constexpr size_t WS_MOD = 1 * MiB;
constexpr size_t WS_ROPE = WS_MOD + 128 * 1024;
constexpr size_t WS_CS = WS_ROPE + 64 * 1024;
constexpr size_t WS_F1T = WS_CS + 512 * 1024;
constexpr size_t WS_TW = WS_F1T + 64 * 1024;
constexpr size_t WS_F2P = WS_TW + 64 * 1024;
constexpr size_t WS_RT = 2 * MiB;
constexpr size_t WS_TOKOF = 3 * MiB;
constexpr size_t WS_WRF = 5 * MiB;
constexpr size_t WS_SSQ = 7 * MiB;
constexpr size_t WS_WIN_T = 8 * MiB;
constexpr size_t WS_WOUT_T = 12 * MiB;
constexpr size_t WS_WGU = 16 * MiB;
constexpr size_t WS_WD = 80 * MiB;
constexpr size_t WS_C = 112 * MiB;
constexpr size_t WS_D = 192 * MiB;
constexpr size_t WS_END = 264 * MiB;
constexpr size_t WS_HL = WS_C, WS_HC = WS_C + (size_t)M * D * 2, WS_AMIX = WS_C, WS_YBUF = WS_C;
constexpr size_t WS_Q = WS_D, WS_K = WS_Q + (size_t)M * 512 * 2, WS_V = WS_K + (size_t)NB * KV * 512 * 2, WS_F = WS_V + (size_t)NB * KV * 512 * 2;
constexpr size_t WS_H2 = WS_D, WS_HMID = WS_D + (size_t)M * D * 2;
static_assert(WS_F + (size_t)M * 512 * 2 <= WS_END && WS_HMID + (size_t)MAXSLOT * DE * 2 <= WS_END, "region D");
constexpr int CW_CNT = 1024;

__device__ __forceinline__ float bf2f(bf16 v) { return __uint_as_float((unsigned)v << 16); }
__device__ __forceinline__ bf16 f2bf(float f) { unsigned u = __float_as_uint(f); return (bf16)((u + 0x7fffu + ((u >> 16) & 1u)) >> 16); }

__global__ void k_mod(const float* c, const float* cctx, const float* w_ada, const float* b_ada, float* modv) {
    const int v = blockIdx.y, j = blockIdx.x * 256 + threadIdx.x;
    const float* cv = v < 2 ? c + v * D : cctx;
    float acc = b_ada[j];
    for (int k = 0; k < D; ++k) { const float s = cv[k]; acc += (s / (1.f + expf(-s))) * w_ada[(size_t)k * 6144 + j]; }
    modv[v * 6144 + j] = acc;
}
__global__ void k_tables(float* rope) {
    const int t = blockIdx.x * 256 + threadIdx.x; if (t >= 128 * 16) return;
    const int pos = t >> 4, i = t & 15;
    const float inv = powf(10000.f, -(float)(2 * i) / 32.f), ang = (float)pos * inv;
    rope[t] = cosf(ang); rope[2048 + t] = sinf(ang);
}
__global__ void k_cvtT(const float* in, int K, int N, size_t istr, bf16* out, int ldo, int coloff, size_t ostr, int mode) {
    const size_t i = (size_t)blockIdx.x * 256 + threadIdx.x; if (i >= (size_t)K * N) return;
    const int e = blockIdx.y; const int k = (int)(i / N), n = (int)(i % N);
    int r = n;
    if (mode == 1) r = (n >> 4) * 32 + (n & 15); else if (mode == 2) r = (n >> 4) * 32 + 16 + (n & 15);
    out[e * ostr + (size_t)r * ldo + coloff + k] = f2bf(in[e * istr + i]);
}
__global__ void k_fft_tables(bf16* f1t, float2* tw, bf16* f2p) {
    const int t = blockIdx.x * 256 + threadIdx.x;
    if (t < 2 * 128 * 128) { const int part = t >> 14, k1 = (t >> 7) & 127, n1 = t & 127; const float x = (float)((k1 * n1) & 127) / 64.f; f1t[t] = f2bf(part ? -sinpif(x) : cospif(x)); }
    if (t < 64 * 128) { const int n2 = t >> 7, k1 = t & 127; const float x = (float)(n2 * k1) / 4096.f; tw[t] = make_float2(cospif(x), -sinpif(x)); }
    if (t < 3 * 64 * 64) { const int tab = t >> 12, k2 = (t >> 6) & 63, pos = t & 63, sp = pos >> 5, quad = (pos >> 3) & 3, jj = pos & 7;
        const int n2 = 32 * sp + (jj < 4 ? 4 * quad + jj : 16 + 4 * quad + (jj - 4)); const float x = (float)((n2 * k2) & 63) / 32.f;
        f2p[t] = f2bf(tab == 0 ? cospif(x) : (tab == 1 ? sinpif(x) : -sinpif(x))); }
}
__global__ void k_fold1(const float* wf, float* cs) {
    const int t = blockIdx.x * 256 + threadIdx.x;
    const int d = t & 127, c = (t >> 7) & 127, part = (t >> 14) & 1, g = t >> 15;
    float acc = 0.f;
    for (int kap = 0; kap < 128; ++kap) { const float x = (float)((c * kap) & 127) / 64.f; const float tr = part ? sinpif(x) : cospif(x); acc += tr * wf[((size_t)g * 128 + kap) * 128 + d]; }
    cs[t] = acc * (1.0f / 1024.0f);
}
__global__ void k_fold2(const float* cs, const float* w_out, bf16* wout_t) {
    const int n = blockIdx.x * 256 + threadIdx.x, kf = blockIdx.y;
    const int g = kf >> 8, c = (kf >> 1) & 127, part = kf & 1;
    const float* csr = cs + (((size_t)g * 2 + part) * 128 + c) * 128;
    float acc = 0.f;
    for (int d = 0; d < 128; ++d) acc += csr[d] * w_out[(size_t)(512 + g * 128 + d) * D + n];
    wout_t[(size_t)n * KO + 512 + kf] = f2bf(acc);
}
__device__ __forceinline__ float block_sum(float v, float* red) {
    for (int o = 1; o < 64; o <<= 1) v += __shfl_xor(v, o);
    __syncthreads(); if ((threadIdx.x & 63) == 0) red[threadIdx.x >> 6] = v; __syncthreads();
    float s = 0.f; for (int w = 0; w < (int)(blockDim.x >> 6); ++w) s += red[w]; return s;
}
__device__ __forceinline__ float block_max(float v, float* red) {
    for (int o = 1; o < 64; o <<= 1) v = fmaxf(v, __shfl_xor(v, o));
    __syncthreads(); if ((threadIdx.x & 63) == 0) red[threadIdx.x >> 6] = v; __syncthreads();
    float s = red[0]; for (int w = 1; w < (int)(blockDim.x >> 6); ++w) s = fmaxf(s, red[w]); return s;
}
__global__ void k_normmod(const float* x, const float* ctx, const float* g, const float* modv, bf16* hl) {
    __shared__ float red[8];
    const int row = blockIdx.x, t = threadIdx.x;
    const float* src = row < M ? x + (size_t)row * D : ctx + (size_t)(row - M) * D;
    const float* mv = modv + (row < M ? (row / S) : 2) * 6144;
    float v[4], ss = 0.f;
    for (int j = 0; j < 4; ++j) { v[j] = src[t + 256 * j]; ss += v[j] * v[j]; }
    const float rs = rsqrtf(block_sum(ss, red) / D + EPS);
    for (int j = 0; j < 4; ++j) { const int k = t + 256 * j; hl[(size_t)row * D + k] = f2bf((v[j] * rs * g[k]) * (1.f + mv[1024 + k]) + mv[k]); }
}

template <class P> __global__ __launch_bounds__(256) void k_gemm(P p) {
    __shared__ float As[32][65], Bs[32][65];
    __shared__ int sb_sh[2];
    if (!p.init(sb_sh)) return;
    const int tid = threadIdx.x, tx = tid & 15, ty = tid >> 4;
    const int lr = tid >> 2, lk = (tid & 3) * 8;
    const bf16* ar = p.arow(lr); const bf16* br = p.brow(lr);
    float acc[4][4] = {};
    for (int k0 = 0; k0 < p.K; k0 += 32) {
        const uint4 av = *(const uint4*)(ar + k0 + lk), bv = *(const uint4*)(br + k0 + lk);
        const unsigned aw[4] = {av.x, av.y, av.z, av.w}, bw[4] = {bv.x, bv.y, bv.z, bv.w};
        __syncthreads();
        for (int i = 0; i < 4; ++i) { As[lk + 2 * i][lr] = __uint_as_float(aw[i] << 16); As[lk + 2 * i + 1][lr] = __uint_as_float(aw[i] & 0xffff0000u);
                                      Bs[lk + 2 * i][lr] = __uint_as_float(bw[i] << 16); Bs[lk + 2 * i + 1][lr] = __uint_as_float(bw[i] & 0xffff0000u); }
        __syncthreads();
        for (int kk = 0; kk < 32; ++kk) { float a[4], b[4];
            for (int i = 0; i < 4; ++i) { a[i] = As[kk][ty + 16 * i]; b[i] = Bs[kk][tx + 16 * i]; }
            for (int i = 0; i < 4; ++i) for (int j = 0; j < 4; ++j) acc[i][j] += a[i] * b[j]; }
    }
    p.epi(ty, tx, acc);
}
struct PInProj {
    const bf16* hl; const bf16* wt; const float* rope; bf16 *Q, *Kb, *Vb, *F; int K;
    __device__ bool init(int*) { return true; }
    __device__ const bf16* arow(int r) const { return hl + (size_t)(blockIdx.y * 64 + r) * D; }
    __device__ const bf16* brow(int n) const { return wt + (size_t)(blockIdx.x * 64 + n) * D; }
    __device__ void epi(int ty, int tx, float (&acc)[4][4]) const {
        const int tn = blockIdx.x * 64, sec = tn >> 9;
        for (int i = 0; i < 4; ++i) { const int row = blockIdx.y * 64 + ty + 16 * i, b = row / S, s = row % S; float o[4];
            if (sec < 2) { const int p0 = s >> 6, p1 = s & 63; const float c0 = rope[p0 * 16 + tx], s0 = rope[2048 + p0 * 16 + tx], c1 = rope[p1 * 16 + tx], s1 = rope[2048 + p1 * 16 + tx];
                o[0] = acc[i][0] * c0 - acc[i][1] * s0; o[1] = acc[i][1] * c0 + acc[i][0] * s0; o[2] = acc[i][2] * c1 - acc[i][3] * s1; o[3] = acc[i][3] * c1 + acc[i][2] * s1;
            } else for (int j = 0; j < 4; ++j) o[j] = acc[i][j];
            for (int j = 0; j < 4; ++j) { const int col = (tn & 511) + tx + 16 * j;
                if (sec == 0) Q[(size_t)row * 512 + col] = f2bf(o[j] * C2);
                else if (sec == 1) Kb[((size_t)b * KV + CTX + s) * 512 + col] = f2bf(o[j]);
                else if (sec == 2) Vb[((size_t)b * KV + CTX + s) * 512 + col] = f2bf(o[j]);
                else { const int g = col >> 7, c = col & 127; F[((((size_t)b * 4 + g) * 32 + (c >> 2)) * S + s) * 4 + (c & 3)] = f2bf(o[j]); } } }
    }
};
struct PCtx {
    const bf16* hc; const bf16* wt; bf16 *Kb, *Vb; int K;
    __device__ bool init(int*) { return true; }
    __device__ const bf16* arow(int r) const { return hc + (size_t)(blockIdx.y * 64 + r) * D; }
    __device__ const bf16* brow(int n) const { return wt + (size_t)(512 + blockIdx.x * 64 + n) * D; }
    __device__ void epi(int ty, int tx, float (&acc)[4][4]) const {
        for (int i = 0; i < 4; ++i) { const int row = blockIdx.y * 64 + ty + 16 * i, b = row / CTX, j0 = row % CTX;
            for (int j = 0; j < 4; ++j) { const int col = blockIdx.x * 64 + tx + 16 * j; bf16* dst = col < 512 ? Kb : Vb;
                dst[((size_t)b * KV + j0) * 512 + (col & 511)] = f2bf(acc[i][j]); } }
    }
};
struct POut {
    const bf16* amix; const bf16* wt; const float* x; const float* modv; float* xl; int K;
    __device__ bool init(int*) { return true; }
    __device__ const bf16* arow(int r) const { return amix + (size_t)(blockIdx.y * 64 + r) * KO; }
    __device__ const bf16* brow(int n) const { return wt + (size_t)(blockIdx.x * 64 + n) * KO; }
    __device__ void epi(int ty, int tx, float (&acc)[4][4]) const {
        for (int i = 0; i < 4; ++i) { const int row = blockIdx.y * 64 + ty + 16 * i, b = row / S;
            for (int j = 0; j < 4; ++j) { const int col = blockIdx.x * 64 + tx + 16 * j; xl[(size_t)row * D + col] = x[(size_t)row * D + col] + modv[b * 6144 + 2048 + col] * acc[i][j]; } }
    }
};
__device__ __forceinline__ int slot_base(const unsigned* cnt, int e) { int sb = 0; for (int i = 0; i < e; ++i) sb += ((int)cnt[i * 64] + 255) >> 8; return sb * 256; }
struct PGateUp {
    const bf16* h2; const bf16* wgu; const unsigned* cnt; const int* tokof; bf16* hmid; int K; int e, n, sb;
    __device__ bool init(int* sh) { e = blockIdx.z; n = (int)cnt[e * 64]; if ((int)blockIdx.y * 64 >= n) return false;
        if (threadIdx.x == 0) sh[0] = slot_base(cnt, e); __syncthreads(); sb = sh[0]; return true; }
    __device__ const bf16* arow(int r) const { const int pos = blockIdx.y * 64 + r; const int tok = pos < n ? tokof[e * 16384 + pos] : 0; return h2 + (size_t)tok * D; }
    __device__ const bf16* brow(int nn) const { return wgu + ((size_t)e * 1024 + blockIdx.x * 64 + nn) * D; }
    __device__ void epi(int ty, int tx, float (&acc)[4][4]) const {
        for (int i = 0; i < 4; ++i) { const int pos = blockIdx.y * 64 + ty + 16 * i; if (pos >= n) continue;
            for (int jj = 0; jj < 2; ++jj) { const float gte = acc[i][2 * jj], up = acc[i][2 * jj + 1]; const int hc = (blockIdx.x * 2 + jj) * 16 + tx;
                hmid[(size_t)(sb + pos) * DE + hc] = f2bf((gte / (1.f + expf(-gte))) * up); } }
    }
};
struct PDown {
    const bf16* hmid; const bf16* wd; const unsigned* cnt; bf16* ybuf; int K; int e, n, sb;
    __device__ bool init(int* sh) { e = blockIdx.z; n = (int)cnt[e * 64]; if ((int)blockIdx.y * 64 >= n) return false;
        if (threadIdx.x == 0) sh[0] = slot_base(cnt, e); __syncthreads(); sb = sh[0]; return true; }
    __device__ const bf16* arow(int r) const { const int pos = blockIdx.y * 64 + r; return hmid + (size_t)(sb + (pos < n ? pos : 0)) * DE; }
    __device__ const bf16* brow(int nn) const { return wd + ((size_t)e * 1024 + blockIdx.x * 64 + nn) * DE; }
    __device__ void epi(int ty, int tx, float (&acc)[4][4]) const {
        for (int i = 0; i < 4; ++i) { const int pos = blockIdx.y * 64 + ty + 16 * i; if (pos >= n) continue;
            for (int j = 0; j < 4; ++j) ybuf[(size_t)(sb + pos) * D + blockIdx.x * 64 + tx + 16 * j] = f2bf(acc[i][j]); }
    }
};

__global__ __launch_bounds__(256) void k_attn(const bf16* Q, const bf16* Kb, const bf16* Vb, bf16* amix, const float* lq1, const float* lk1, const float* lq2, const float* lk2, const float* gsub) {
    extern __shared__ float sm[];
    float* s0 = sm; float* s1 = sm + KV; float* qs = sm + 2 * KV; float* red = qs + 128; float* osh = red + 8;
    const int row = blockIdx.x, h = blockIdx.y, b = row / S, t = threadIdx.x;
    if (t < 128) qs[t] = bf2f(Q[(size_t)row * 512 + h * 128 + t]);
    __syncthreads();
    float m0 = -1e30f, m1 = -1e30f;
    for (int key = t; key < KV; key += 256) { const bf16* kr = Kb + ((size_t)b * KV + key) * 512 + h * 128; float d0 = 0.f, d1 = 0.f;
        for (int d = 0; d < 64; ++d) { d0 += qs[d] * bf2f(kr[d]); d1 += qs[64 + d] * bf2f(kr[64 + d]); }
        s0[key] = d0; s1[key] = d1; m0 = fmaxf(m0, d0); m1 = fmaxf(m1, d1); }
    m0 = block_max(m0, red); m1 = block_max(m1, red);
    float l0 = 0.f, l1 = 0.f;
    for (int key = t; key < KV; key += 256) { const float p0 = exp2f(s0[key] - m0), p1 = exp2f(s1[key] - m1); s0[key] = p0; s1[key] = p1; l0 += p0; l1 += p1; }
    l0 = block_sum(l0, red); l1 = block_sum(l1, red);
    float a1 = 0.f, a2 = 0.f; for (int d = 0; d < 64; ++d) { a1 += lq1[d] * lk1[d]; a2 += lq2[d] * lk2[d]; }
    const float lam = expf(a1) - expf(a2) + 0.2f;
    const float i0 = 1.f / l0, i1 = lam / l1;
    for (int key = t; key < KV; key += 256) s0[key] = s0[key] * i0 - s1[key] * i1;
    __syncthreads();
    const int dv = t & 127, half = t >> 7; float o = 0.f;
    for (int key = half * (KV / 2); key < (half + 1) * (KV / 2); ++key) o += s0[key] * bf2f(Vb[((size_t)b * KV + key) * 512 + h * 128 + dv]);
    osh[t] = o; __syncthreads();
    o = osh[dv] + osh[128 + dv];
    const float ms = block_sum(t < 128 ? o * o : 0.f, red) / 128.f;
    if (t < 128) amix[(size_t)row * KO + h * 128 + dv] = f2bf(o * rsqrtf(ms + EPS) * gsub[dv] * 0.8f);
}
__global__ __launch_bounds__(256) void k_fft(const bf16* F, bf16* amix) {
    extern __shared__ float sm[];
    float2* tab = (float2*)sm; bf16* xs = (bf16*)(sm + 2 * 8192);
    const int u = blockIdx.y, t = threadIdx.x;
    for (int j = t; j < 8192; j += 256) { float sn, cs; sincospif((float)j / 4096.f, &sn, &cs); tab[j] = make_float2(cs, sn); }
    const bf16* xg = F + (size_t)u * S * 4;
    for (int j = t; j < S * 4 / 8; j += 256) ((uint4*)xs)[j] = ((const uint4*)xg)[j];
    __syncthreads();
    const int c = t & 3, k = blockIdx.x * 64 + (t >> 2);
    float re = 0.f, im = 0.f;
    for (int n = 0; n < S; ++n) { const float2 w = tab[(n * k) & 8191]; const float xv = bf2f(xs[n * 4 + c]); re += xv * w.x; im -= xv * w.y; }
    const int b = u >> 7, g = (u >> 5) & 3, cq = u & 31;
    bf16* dst = amix + ((size_t)b * S + k) * KO + 512 + g * 256 + 2 * (cq * 4 + c);
    dst[0] = f2bf(re); dst[1] = f2bf(im);
}
__global__ __launch_bounds__(256) void k_router(const float* xl, const float* gffn, const float* modv, const float* wrg, const float* brg, const float* wre, const float* bre,
                                                bf16* h2, unsigned* cnt, int* tokof, int* expid, int* posb, float* gate, const float* ssq16) {
    __shared__ float red[8]; __shared__ float hs[D]; __shared__ float lg[36];
    const int row = blockIdx.x, t = threadIdx.x, b = row / S;
    float v[4], ss = 0.f;
    for (int j = 0; j < 4; ++j) { v[j] = xl[(size_t)row * D + t + 256 * j]; ss += v[j] * v[j]; }
    float tot = block_sum(ss, red);
    if (ssq16) { tot = 0.f; for (int j = 0; j < 16; ++j) tot += ssq16[(size_t)row * 16 + j]; }
    const float rs = rsqrtf(tot / D + EPS);
    const float* mv = modv + b * 6144;
    for (int j = 0; j < 4; ++j) { const int k = t + 256 * j; const float hv = (v[j] * rs * gffn[k]) * (1.f + mv[4096 + k]) + mv[3072 + k]; hs[k] = hv; h2[(size_t)row * D + k] = f2bf(hv); }
    __syncthreads();
    const int w = t >> 6, lane = t & 63;
    for (int o = w; o < 36; o += 4) { float a = 0.f;
        for (int k = lane; k < D; k += 64) a += hs[k] * (o < 4 ? wrg[k * 4 + o] : wre[k * 32 + (o - 4)]);
        for (int s = 1; s < 64; s <<= 1) a += __shfl_xor(a, s);
        if (lane == 0) lg[o] = a + (o < 4 ? brg[o] : bre[o - 4]); }
    __syncthreads();
    if (t == 0) {
        int grp = 0; for (int i = 1; i < 4; ++i) if (lg[i] > lg[grp]) grp = i;
        float se = 0.f; for (int i = 0; i < 4; ++i) se += expf(lg[i] - lg[grp]);
        const float pg = 1.f / se;
        const float* el = lg + 4 + grp * 8;
        int i0 = 0; for (int i = 1; i < 8; ++i) if (el[i] > el[i0]) i0 = i;
        int i1 = (i0 == 0) ? 1 : 0; for (int i = 0; i < 8; ++i) if (i != i0 && el[i] > el[i1]) i1 = i;
        const float e1 = expf(el[i1] - el[i0]), g0 = pg / (1.f + e1), g1 = pg * e1 / (1.f + e1);
        const int ex[2] = {grp * 8 + i0, grp * 8 + i1}; const float gg[2] = {g0, g1};
        for (int k = 0; k < 2; ++k) { const int pos = (int)atomicAdd(&cnt[ex[k] * 64], 1u); tokof[ex[k] * 16384 + pos] = row;
            expid[row * 2 + k] = ex[k]; posb[row * 2 + k] = pos; gate[row * 2 + k] = gg[k]; }
    }
}
__global__ __launch_bounds__(256) void k_final(const float* xl, const bf16* ybuf, const unsigned* cnt, const int* expid, const int* posb, const float* gate, const float* modv, const float* gfin, float* out) {
    __shared__ float red[8]; __shared__ int sl[2];
    const int row = blockIdx.x, t = threadIdx.x, b = row / S;
    if (t < 2) sl[t] = slot_base(cnt, expid[row * 2 + t]) + posb[row * 2 + t];
    __syncthreads();
    const bf16* y0 = ybuf + (size_t)sl[0] * D; const bf16* y1 = ybuf + (size_t)sl[1] * D;
    float v[4], ss = 0.f;
    for (int j = 0; j < 4; ++j) { const int k = t + 256 * j; v[j] = xl[(size_t)row * D + k] + modv[b * 6144 + 5120 + k] * (gate[row * 2] * bf2f(y0[k]) + gate[row * 2 + 1] * bf2f(y1[k])); ss += v[j] * v[j]; }
    const float rs = rsqrtf(block_sum(ss, red) / D + EPS);
    for (int j = 0; j < 4; ++j) { const int k = t + 256 * j; out[(size_t)row * D + k] = v[j] * rs * gfin[k]; }
}

namespace pg8 {
#define PG8_LAS __attribute__((address_space(3)))
typedef unsigned short bf16_t;
typedef short bf16x8 __attribute__((ext_vector_type(8)));
typedef float f32x4 __attribute__((ext_vector_type(4)));
typedef unsigned u32x4 __attribute__((ext_vector_type(4)));
constexpr int BM = 256, BK = 64, HALF = 128, HTB = HALF * BK * 2  , STAGE_BYTES = 8 * HTB, NXCD = 8, WGM = 8;

__host__ __device__ __forceinline__ int lds_byte(int r, int c) { const int st = (r >> 4) * 2 + (c >> 5), rr = r & 15, cc = c & 31, ob = rr * 64 + cc * 2; return st * 1024 + (ob ^ (((ob >> 9) & 1) << 5)); }
__host__ __device__ __forceinline__ void stage_rc(int b, int& R, int& C) { const int st = b / 1024, sb = b % 1024, swz = sb ^ (((sb >> 9) & 1) << 5); R = (st >> 1) * 16 + swz / 64; C = (st & 1) * 32 + (swz % 64) / 2; }
__host__ __device__ __forceinline__ int perm32(int rho) { const int n = rho >> 4, i = rho & 15; return 8 * (i >> 2) + 4 * n + (i & 3); }

struct Unit { int pm, pn; };
struct Gemm { const bf16_t* A; const bf16_t* Bt; int M, N, K; };

struct StaticOrder {
    int nM, nN, nwg, G, c;
    __host__ __device__ void init(int M, int N, int G_, int c_) { nM = M / BM; nN = N / BM; nwg = nM * nN; G = G_; c = c_; }
    __host__ __device__ bool next(int i, Unit& u) const {
        const long L = (long)i * G + c; if (L >= nwg) return false;
        int wgid = (int)L; { const int q = nwg / NXCD, r = nwg % NXCD, xcd = wgid % NXCD, off = wgid / NXCD; wgid = (xcd < r ? xcd * (q + 1) : r * (q + 1) + (xcd - r) * q) + off; }
        const int nig = WGM * nN, gid = wgid / nig, fm = gid * WGM, gsz = (nM - fm) < WGM ? (nM - fm) : WGM;
        u.pm = fm + ((wgid % nig) % gsz); u.pn = (wgid % nig) / gsz; return true;
    }
    __device__ __forceinline__ void a_ready(const Unit&) const {}
    __device__ __forceinline__ void done(const Unit&) const {}
};

__device__ __forceinline__ unsigned cvt_pk_bf16(float lo, float hi) { typedef float f32x2_t __attribute__((ext_vector_type(2))); typedef __bf16 bf16x2_t __attribute__((ext_vector_type(2))); const f32x2_t v = {lo, hi}; return __builtin_bit_cast(unsigned, __builtin_convertvector(v, bf16x2_t)); }
typedef unsigned u32x2 __attribute__((ext_vector_type(2)));
__device__ __forceinline__ u32x2 pack4(f32x4 v) { u32x2 w; w.x = cvt_pk_bf16(v[0], v[1]); w.y = cvt_pk_bf16(v[2], v[3]); return w; }
struct EpiInProj {
    static constexpr bool PERM = false, AFTER_DRAIN = false;
    bf16_t *Q, *Kb, *Vb, *F; const float* rope;
    __device__ __forceinline__ void operator()(const f32x4 (&acc)[2][2][4][2], const Unit& u, int wr, int wc, int fr, int fq) const {
        const int sec = u.pn >> 1, colh = (u.pn & 1) * 256 + wc * 32 + 4 * fq;
#pragma unroll
        for (int ai = 0; ai < 2; ++ai)
#pragma unroll
            for (int m = 0; m < 4; ++m) {
                const int row = u.pm * BM + ai * HALF + wr * 64 + m * 16 + fr, b = row >> 13, s = row & 8191;
                if (sec < 2) {
                    const int pos = (wc & 1) ? (s & 63) : (s >> 6);
                    const f32x4 cs = *(const f32x4*)(rope + pos * 16 + 4 * fq), sn = *(const f32x4*)(rope + 2048 + pos * 16 + 4 * fq);
                    bf16_t* dst = sec == 0 ? Q + (size_t)row * 512 + colh : Kb + ((size_t)b * 8448 + 256 + s) * 512 + colh;
                    const float sc = sec == 0 ? 0.125f * 1.4426950408889634f : 1.f;
#pragma unroll
                    for (int bj = 0; bj < 2; ++bj) { const f32x4 x1 = acc[ai][bj][m][0], x2 = acc[ai][bj][m][1];
                        *(u32x2*)(dst + bj * HALF) = pack4((x1 * cs - x2 * sn) * sc); *(u32x2*)(dst + bj * HALF + 16) = pack4((x2 * cs + x1 * sn) * sc); }
                } else if (sec == 2) {
                    bf16_t* dst = Vb + ((size_t)b * 8448 + 256 + s) * 512 + colh;
#pragma unroll
                    for (int bj = 0; bj < 2; ++bj) { *(u32x2*)(dst + bj * HALF) = pack4(acc[ai][bj][m][0]); *(u32x2*)(dst + bj * HALF + 16) = pack4(acc[ai][bj][m][1]); }
                } else {
#pragma unroll
                    for (int bj = 0; bj < 2; ++bj)
#pragma unroll
                        for (int n = 0; n < 2; ++n) { const int g = (u.pn & 1) * 2 + bj, cq = 8 * wc + 4 * n + fq;
                            *(u32x2*)(F + ((((size_t)b * 4 + g) * 32 + cq) * 8192 + s) * 4) = pack4(acc[ai][bj][m][n]); }
                }
            }
    }
};
struct EpiOut {
    static constexpr bool PERM = false, AFTER_DRAIN = false;
    const float* x; const float* modv; float* xl; float* ssq;
    __device__ __forceinline__ void operator()(const f32x4 (&acc)[2][2][4][2], const Unit& u, int wr, int wc, int fr, int fq) const {
        const int col0 = u.pn * BM + wc * 32 + 4 * fq;
#pragma unroll
        for (int ai = 0; ai < 2; ++ai)
#pragma unroll
            for (int m = 0; m < 4; ++m) {
                const int row = u.pm * BM + ai * HALF + wr * 64 + m * 16 + fr, b = row >> 13; const size_t off = (size_t)row * 1024 + col0; const float* gt = modv + b * 6144 + 2048 + col0;
                float ss = 0.f;
#pragma unroll
                for (int bj = 0; bj < 2; ++bj)
#pragma unroll
                    for (int n = 0; n < 2; ++n) { const f32x4 xv = *(const f32x4*)(x + off + bj * HALF + n * 16), gv = *(const f32x4*)(gt + bj * HALF + n * 16);
                        const f32x4 o = xv + gv * acc[ai][bj][m][n]; *(f32x4*)(xl + off + bj * HALF + n * 16) = o; ss += (o[0] * o[0] + o[1] * o[1]) + (o[2] * o[2] + o[3] * o[3]); }
                ss += __shfl_xor(ss, 16); ss += __shfl_xor(ss, 32);
                if (fq == 0) ssq[(size_t)row * 16 + u.pn * 4 + wc] = ss;
                if (m & 1) asm volatile("" ::: "memory");
            }
    }
};
struct EpiGateUp {
    static constexpr bool PERM = false, AFTER_DRAIN = false;
    bf16_t* hmid;
    __device__ __forceinline__ void operator()(const f32x4 (&acc)[2][2][4][2], const Unit& u, int wr, int wc, int fr, int fq) const {
#pragma unroll
        for (int ai = 0; ai < 2; ++ai)
#pragma unroll
            for (int m = 0; m < 4; ++m) { const int slot = u.pm * BM + ai * HALF + wr * 64 + m * 16 + fr;
#pragma unroll
                for (int bj = 0; bj < 2; ++bj) { const f32x4 gv = acc[ai][bj][m][0], uv = acc[ai][bj][m][1]; f32x4 o;
#pragma unroll
                    for (int j = 0; j < 4; ++j) o[j] = gv[j] * __builtin_amdgcn_rcpf(1.f + __builtin_amdgcn_exp2f(-1.4426950408889634f * gv[j])) * uv[j];
                    *(u32x2*)(hmid + (size_t)slot * 512 + (8 * (u.pn & 3) + 4 * bj + wc) * 16 + 4 * fq) = pack4(o); } }
    }
};
struct EpiDown {
    static constexpr bool PERM = true, AFTER_DRAIN = false;
    bf16_t* ybuf;
    __device__ __forceinline__ void operator()(const f32x4 (&acc)[2][2][4][2], const Unit& u, int wr, int wc, int fr, int fq) const {
        const int col0 = (u.pn & 3) * BM + wc * 32 + 8 * fq;
#pragma unroll
        for (int ai = 0; ai < 2; ++ai)
#pragma unroll
            for (int m = 0; m < 4; ++m) { bf16_t* rowp = ybuf + (size_t)(u.pm * BM + ai * HALF + wr * 64 + m * 16 + fr) * 1024 + col0;
#pragma unroll
                for (int bj = 0; bj < 2; ++bj) { const f32x4 v0 = acc[ai][bj][m][0], v1 = acc[ai][bj][m][1]; u32x4 w; w.x = cvt_pk_bf16(v0[0], v0[1]); w.y = cvt_pk_bf16(v0[2], v0[3]); w.z = cvt_pk_bf16(v1[0], v1[1]); w.w = cvt_pk_bf16(v1[2], v1[3]);
                    *(u32x4*)(rowp + bj * HALF) = w; } }
    }
};
struct MoeOrder {
    int nunits, G, c; const PG8_LAS int* tb; const PG8_LAS int* toks;
    __device__ __forceinline__ bool next(int i, Unit& u) const {
        const int L = i * G + c; if (L >= nunits) return false;
        const int tile = L >> 2; int e = 0;
        for (int j = 1; j < 32; ++j) e += (tb[j] <= tile) ? 1 : 0;
        u.pm = tile; u.pn = e * 4 + (L & 3); return true;
    }
    __device__ __forceinline__ int arow(int i, int r) const { return toks[i * 256 + r]; }
    __device__ __forceinline__ void a_ready(const Unit&) const {}
    __device__ __forceinline__ void done(const Unit&) const {}
};
template <class Epi, class Sched, bool ALIGN_EPI = false, bool SP2 = false, bool GATHER = false>
__device__ __forceinline__ void gemm_phase(PG8_LAS unsigned char* lds, const Gemm g, const Sched& S, const Epi& E) {
    const int tid = threadIdx.x, wid = __builtin_amdgcn_readfirstlane(tid >> 6), lane = tid & 63, wr = wid >> 2, wc = wid & 3, fr = lane & 15, fq = lane >> 4;
    const int K = g.K, nt = K / BK;
    unsigned voffA[2], voffB[2]; int gR0 = 0; unsigned gC0 = 0u;
    unsigned vA[2][2];
#pragma unroll
    for (int i = 0; i < 2; ++i) { int R, C; stage_rc(tid * 16 + i * 8192, R, C); const int Rb = Epi::PERM ? ((R & ~31) + perm32(R & 31)) : R;
        voffA[i] = (unsigned)(R * K + C) * 2u; voffB[i] = (unsigned)(Rb * K + C) * 2u; if (i == 0) { gR0 = R; gC0 = (unsigned)C * 2u; } }
    const size_t kstep = (size_t)(BK * 2);
    const size_t hstep = (size_t)HALF * K * 2;
    const size_t tstep = 2 * hstep;
    const unsigned ldsw = (unsigned)wid * 1024u;
    const int aoff = lds_byte(wr * 64 + fr, fq * 8), boff = lds_byte(wc * 32 + fr, fq * 8);
#define PG8_SA(b, h) (((b) * 2 + (h)) * HTB)
#define PG8_SB(b, h) ((4 + (b) * 2 + (h)) * HTB)
#define PG8_STAGE(bufoff, gbase, voff) do { _Pragma("unroll") for (int _i = 0; _i < 2; ++_i) \
        __builtin_amdgcn_global_load_lds((const unsigned*)((const char*)(gbase) + (voff)[_i]), (PG8_LAS unsigned*)(lds + (bufoff) + ldsw + _i * 8192), 16, 0, 0); } while (0)
#define PG8_STAGE_A(bufoff, gbase, h, nx) do { if constexpr (GATHER) { PG8_STAGE(bufoff, gbase, vA[h]); } else { PG8_STAGE(bufoff, (gbase) + (h) * hstep, voffA); } } while (0)
#define PG8_GATHER_OFFS(dst, uidx) do { _Pragma("unroll") for (int _h = 0; _h < 2; ++_h) _Pragma("unroll") for (int _i = 0; _i < 2; ++_i) dst[_h][_i] = (unsigned)S.arow(uidx, _h * HALF + gR0 + 64 * _i) * (unsigned)(K * 2) + gC0; } while (0)
#define PG8_LDA(dst, b, h) do { _Pragma("unroll") for (int m = 0; m < 4; ++m) _Pragma("unroll") for (int k = 0; k < 2; ++k) dst[m][k] = *(const PG8_LAS bf16x8*)(lds + PG8_SA(b, h) + aoff + m * 2048 + k * 1024); } while (0)
#define PG8_LDB(dst, b, h) do { _Pragma("unroll") for (int n = 0; n < 2; ++n) _Pragma("unroll") for (int k = 0; k < 2; ++k) dst[n][k] = *(const PG8_LAS bf16x8*)(lds + PG8_SB(b, h) + boff + n * 2048 + k * 1024); } while (0)
#define PG8_MMA(ai, bj, At, Bt) do { __builtin_amdgcn_s_setprio(1); _Pragma("unroll") for (int m = 0; m < 4; ++m) _Pragma("unroll") for (int n = 0; n < 2; ++n) _Pragma("unroll") for (int k = 0; k < 2; ++k) \
        acc[ai][bj][m][n] = __builtin_amdgcn_mfma_f32_16x16x32_bf16(Bt[n][k], At[m][k], acc[ai][bj][m][n], 0, 0, 0); __builtin_amdgcn_s_setprio(0); } while (0)
#define PG8_WAIT_V(n) asm volatile("s_waitcnt vmcnt(" #n ")" ::: "memory")
#define PG8_WAIT_L(n) asm volatile("s_waitcnt lgkmcnt(" #n ")" ::: "memory")
#define PG8_BAR __builtin_amdgcn_s_barrier()
#define PG8_SCHED __builtin_amdgcn_sched_barrier(0)
    Unit cur, nxt; int ui = 0;
    if (!S.next(0, cur)) return;
    f32x4 acc[2][2][4][2];
#pragma unroll
    for (int a = 0; a < 2; ++a)
#pragma unroll
        for (int b = 0; b < 2; ++b)
#pragma unroll
            for (int m = 0; m < 4; ++m)
#pragma unroll
                for (int n = 0; n < 2; ++n) acc[a][b][m][n] = (f32x4){0.f, 0.f, 0.f, 0.f};
    bf16x8 At[4][2], B0[2][2], B1[2][2];
    const char* cA = GATHER ? (const char*)g.A : (const char*)g.A + (size_t)cur.pm * tstep; const char* cB = (const char*)g.Bt + (size_t)cur.pn * tstep;
    if constexpr (GATHER) { PG8_GATHER_OFFS(vA, 0); }
    S.a_ready(cur);
    if constexpr (SP2) {
        PG8_STAGE(PG8_SB(0, 0), cB, voffB); PG8_STAGE(PG8_SB(0, 1), cB + hstep, voffB); PG8_STAGE_A(PG8_SA(0, 0), cA, 0, false); PG8_STAGE_A(PG8_SA(0, 1), cA, 1, false);
        if (wr == 1) PG8_BAR;
        PG8_WAIT_V(2); PG8_BAR;
        PG8_STAGE(PG8_SB(1, 0), cB + kstep, voffB); PG8_STAGE_A(PG8_SA(1, 0), cA + kstep, 0, false); PG8_STAGE(PG8_SB(1, 1), cB + hstep + kstep, voffB);
        PG8_WAIT_V(6); PG8_BAR;
    } else {
        PG8_STAGE(PG8_SB(0, 0), cB, voffB); PG8_STAGE_A(PG8_SA(0, 0), cA, 0, false); PG8_STAGE(PG8_SB(0, 1), cB + hstep, voffB); PG8_STAGE_A(PG8_SA(0, 1), cA, 1, false);
        if (wr == 1) PG8_BAR;
        PG8_WAIT_V(4); PG8_BAR;
        PG8_STAGE(PG8_SB(1, 0), cB + kstep, voffB); PG8_STAGE_A(PG8_SA(1, 0), cA + kstep, 0, false); PG8_STAGE(PG8_SB(1, 1), cB + hstep + kstep, voffB);
        PG8_WAIT_V(6); PG8_BAR;
    }
    for (;;) {
        const bool has_next = S.next(ui + 1, nxt);
        const char* nA = GATHER ? cA : (has_next ? (const char*)g.A + (size_t)nxt.pm * tstep : cA); const char* nB = has_next ? (const char*)g.Bt + (size_t)nxt.pn * tstep : cB;

        for (int t = 0; t < nt; t += 2) {
            const bool last = (t == nt - 2);
            const char* a1 = cA + (size_t)(t + 1) * kstep;
            const char* a2 = last ? nA : cA + (size_t)(t + 2) * kstep; const char* b2 = last ? nB : cB + (size_t)(t + 2) * kstep;
            const char* a3 = a2 + kstep; const char* b3 = b2 + kstep;
            if (last && has_next) S.a_ready(nxt);
            if constexpr (SP2) {
            PG8_LDB(B0, 0, 0); PG8_LDB(B1, 0, 1); PG8_SCHED; PG8_LDA(At, 0, 0); PG8_STAGE_A(PG8_SA(1, 1), a1, 1, false);
            if constexpr (GATHER) { if (last && has_next) { PG8_GATHER_OFFS(vA, ui + 1); } }
            PG8_WAIT_V(8); PG8_WAIT_L(0); PG8_BAR; PG8_MMA(0, 0, At, B0); PG8_MMA(0, 1, At, B1); PG8_BAR; PG8_SCHED;
            PG8_LDA(At, 0, 1); PG8_STAGE(PG8_SB(0, 0), b2, voffB); PG8_STAGE(PG8_SB(0, 1), b2 + hstep, voffB); PG8_STAGE_A(PG8_SA(0, 0), a2, 0, last);
            PG8_WAIT_V(8); PG8_WAIT_L(0); PG8_BAR; PG8_MMA(1, 0, At, B0); PG8_MMA(1, 1, At, B1); PG8_BAR; PG8_SCHED;
            PG8_LDB(B0, 1, 0); PG8_LDB(B1, 1, 1); PG8_SCHED; PG8_LDA(At, 1, 0); PG8_STAGE_A(PG8_SA(0, 1), a2, 1, last);
            PG8_WAIT_V(8); PG8_WAIT_L(0); PG8_BAR; PG8_MMA(0, 0, At, B0); PG8_MMA(0, 1, At, B1); PG8_BAR; PG8_SCHED;
            PG8_LDA(At, 1, 1); PG8_STAGE(PG8_SB(1, 0), b3, voffB); PG8_STAGE(PG8_SB(1, 1), b3 + hstep, voffB); PG8_STAGE_A(PG8_SA(1, 0), a3, 0, last);
            PG8_WAIT_V(8); PG8_WAIT_L(0); PG8_BAR; PG8_MMA(1, 0, At, B0); PG8_MMA(1, 1, At, B1); PG8_BAR; PG8_SCHED;
            } else {
            PG8_LDB(B0, 0, 0); PG8_SCHED; PG8_LDA(At, 0, 0); PG8_STAGE_A(PG8_SA(1, 1), a1, 1, false);
            if constexpr (GATHER) { if (last && has_next) { PG8_GATHER_OFFS(vA, ui + 1); } }
            PG8_WAIT_L(8); PG8_BAR; PG8_WAIT_L(0); PG8_MMA(0, 0, At, B0); PG8_BAR; PG8_SCHED;
            PG8_LDB(B1, 0, 1); PG8_STAGE(PG8_SB(0, 0), b2, voffB);
            PG8_BAR; PG8_WAIT_L(0); PG8_MMA(0, 1, At, B1); PG8_BAR;
            PG8_LDA(At, 0, 1); PG8_STAGE_A(PG8_SA(0, 0), a2, 0, last);
            PG8_BAR; PG8_WAIT_L(0); PG8_MMA(1, 0, At, B0); PG8_BAR; PG8_SCHED;
            PG8_STAGE(PG8_SB(0, 1), b2 + hstep, voffB);
            PG8_WAIT_V(6); PG8_BAR; PG8_MMA(1, 1, At, B1); PG8_BAR;
            PG8_LDB(B0, 1, 0); PG8_SCHED; PG8_LDA(At, 1, 0); PG8_STAGE_A(PG8_SA(0, 1), a2, 1, last);
            PG8_WAIT_L(8); PG8_BAR; PG8_WAIT_L(0); PG8_MMA(0, 0, At, B0); PG8_BAR; PG8_SCHED;
            PG8_LDB(B1, 1, 1); PG8_STAGE(PG8_SB(1, 0), b3, voffB);
            PG8_BAR; PG8_WAIT_L(0); PG8_MMA(0, 1, At, B1); PG8_BAR;
            PG8_LDA(At, 1, 1); PG8_STAGE_A(PG8_SA(1, 0), a3, 0, last);
            PG8_BAR; PG8_WAIT_L(0); PG8_MMA(1, 0, At, B0); PG8_BAR; PG8_SCHED;
            PG8_STAGE(PG8_SB(1, 1), b3 + hstep, voffB);
            PG8_WAIT_V(6); PG8_BAR; PG8_MMA(1, 1, At, B1); PG8_BAR;
            }
        }
        if constexpr (ALIGN_EPI) { if (wr == 0) PG8_BAR; }
        if constexpr (!Epi::AFTER_DRAIN) { E(acc, cur, wr, wc, fr, fq); S.done(cur); }
        if (!has_next) break;
#pragma unroll
        for (int a = 0; a < 2; ++a)
#pragma unroll
            for (int b = 0; b < 2; ++b)
#pragma unroll
                for (int m = 0; m < 4; ++m)
#pragma unroll
                    for (int n = 0; n < 2; ++n) acc[a][b][m][n] = (f32x4){0.f, 0.f, 0.f, 0.f};
        cur = nxt; cA = nA; cB = nB; ++ui;
        if constexpr (ALIGN_EPI) { if (wr == 1) PG8_BAR; }
    }
    PG8_WAIT_V(0);
    if constexpr (!ALIGN_EPI) { if (wr == 0) PG8_BAR; }
    PG8_BAR;
    if constexpr (Epi::AFTER_DRAIN) { E.fused(acc, cur, wr, wc, fr, fq, lds, wid, lane); S.done(cur); }
#undef PG8_SA
#undef PG8_SB
#undef PG8_STAGE
#undef PG8_STAGE_A
#undef PG8_GATHER_OFFS
#undef PG8_LDA
#undef PG8_LDB
#undef PG8_MMA
#undef PG8_WAIT_V
#undef PG8_WAIT_L
#undef PG8_BAR
#undef PG8_SCHED
}
}

#define GAS __attribute__((address_space(1)))
#define LAS __attribute__((address_space(3)))
typedef GAS unsigned gu32;
#define RLX_AGENT __ATOMIC_RELAXED, __HIP_MEMORY_SCOPE_AGENT
#define LDS_WAIT() asm volatile("s_waitcnt lgkmcnt(0)" ::: "memory")
#define VM_WAIT() asm volatile("s_waitcnt vmcnt(0)" ::: "memory")

#define XB_TMO      128
#define XB_XCNT(j)  (256  + 64 * (j))
#define XB_XSUB(j)  (1280 + 64 * (j))
#define XB_XGEN(j)  (2304 + 64 * (j))
#define XB_TOP      3328
#define XB_TOPGEN   3392
#define XCD_BAR_WORDS 3456
#define XB_SPIN_CAP (1u << 18)

__device__ __forceinline__ unsigned xb_ld(unsigned* p)              { return __hip_atomic_load(p, __ATOMIC_RELAXED, __HIP_MEMORY_SCOPE_AGENT); }
__device__ __forceinline__ unsigned xb_add(unsigned* p, unsigned v) { return __hip_atomic_fetch_add(p, v, __ATOMIC_RELAXED, __HIP_MEMORY_SCOPE_AGENT); }
__device__ __forceinline__ unsigned xb_xcc_id() { return (unsigned)__builtin_amdgcn_s_getreg((3 << 11) | 20) & 0xFu; }
#define XB_SPIN(cond, bar) do { unsigned _sp = 0; while (cond) { __builtin_amdgcn_s_sleep(1); \
    if ((++_sp & 255u) == 0u) { if (xb_ld(&(bar)[XB_TMO])) break; if (_sp > XB_SPIN_CAP) { atomicAdd(&(bar)[XB_TMO], 1u); break; } } } } while (0)

struct XcdBarrier {
    unsigned* bar; unsigned x;
    volatile LAS unsigned* st;
};

__device__ __forceinline__ XcdBarrier xcd_barrier_post(unsigned* bar, volatile LAS unsigned* st) {
    XcdBarrier b; b.bar = bar; b.x = xb_xcc_id(); b.st = st;
    if (threadIdx.x == 0) (void)xb_add(&bar[XB_XCNT(b.x)], 1u);
    return b;
}
__device__ __forceinline__ void xcd_barrier_complete(unsigned* bar, unsigned x, unsigned& nloc, unsigned& nx) {
    const unsigned G = gridDim.x * gridDim.y * gridDim.z;
    unsigned sum, cnt, mine, sp = 0u;
    for (;;) {
        sum = 0u; cnt = 0u; mine = 0u;
#pragma unroll
        for (unsigned j = 0; j < 16; ++j) { const unsigned c = xb_ld(&bar[XB_XCNT(j)]); sum += c; cnt += (c > 0u) ? 1u : 0u; mine = (j == x) ? c : mine; }
        if (sum == G) break;
        __builtin_amdgcn_s_sleep(1);
        if ((++sp & 255u) == 0u) { if (xb_ld(&bar[XB_TMO])) break; if (sp > XB_SPIN_CAP) { atomicAdd(&bar[XB_TMO], 1u); break; } }
    }
    nloc = mine > 0u ? mine : 1u; nx = cnt > 0u ? cnt : 1u;
}

__device__ __forceinline__ void xcd_barrier(const XcdBarrier& b) {
    asm volatile("s_waitcnt vmcnt(0)" ::: "memory");
    __syncthreads();
    if (threadIdx.x == 0) {
        unsigned* bar = b.bar;
        __builtin_amdgcn_s_waitcnt(0);
        unsigned nloc = b.st[0], nx = b.st[1];
        if (nloc == 0u) { xcd_barrier_complete(bar, b.x, nloc, nx); b.st[0] = nloc; b.st[1] = nx; }
        const unsigned old = xb_add(&bar[XB_XSUB(b.x)], 1u);
        const unsigned gen = old / nloc;
        if (old + 1u == (gen + 1u) * nloc) {
            __builtin_amdgcn_fence(__ATOMIC_RELEASE, "agent");
            asm volatile("s_waitcnt vmcnt(0)" ::: "memory");
            const unsigned og = xb_add(&bar[XB_TOP], 1u);
            const unsigned tg = og / nx;
            if (og + 1u == (tg + 1u) * nx) xb_add(&bar[XB_TOPGEN], 1u);
            else XB_SPIN(xb_ld(&bar[XB_TOPGEN]) == tg, bar);
            __builtin_amdgcn_fence(__ATOMIC_ACQUIRE, "agent");
            xb_add(&bar[XB_XGEN(b.x)], 1u);
            asm volatile("s_waitcnt vmcnt(0)" ::: "memory");
        } else {
            XB_SPIN(xb_ld(&bar[XB_XGEN(b.x)]) == gen, bar);
            __builtin_amdgcn_fence(__ATOMIC_ACQUIRE, "agent");
            asm volatile("s_waitcnt vmcnt(0)" ::: "memory");
        }
    }
    __syncthreads();
}

namespace da {
using bf16x8 = __attribute__((ext_vector_type(8))) short;
using s16x4  = __attribute__((ext_vector_type(4))) short;
using f32x16 = __attribute__((ext_vector_type(16))) float;
using u32x4  = __attribute__((ext_vector_type(4))) unsigned;
constexpr int NW = 8, QBLK = 32, KVBLK = 64, LDK = 512;
constexpr int SHM_V = KVBLK * 128 * 2, SHM_K = KVBLK * 128 * 2, SHM_ATTN = 2 * SHM_V + 2 * SHM_K + NW * 64 * 4;
constexpr float THRL = 8.f;
#define DA_KSWZ(row, colB) ((row) * 256 + ((colB) ^ (((row) & 7) << 4)))
#define DA_SBAR() __builtin_amdgcn_sched_barrier(0)
__device__ __forceinline__ int crow(int r, int hi) { return (r & 3) + 8 * (r >> 2) + 4 * hi; }
__device__ __forceinline__ unsigned cvtpk(float lo, float hi) { typedef float f32x2_t __attribute__((ext_vector_type(2))); typedef __bf16 bf16x2_t __attribute__((ext_vector_type(2))); const f32x2_t v = {lo, hi}; return __builtin_bit_cast(unsigned, __builtin_convertvector(v, bf16x2_t)); }
__device__ __forceinline__ void partialSM(f32x16& p0, f32x16& p1, float& m_reg, float& mn, float& alpha) {
  float pmax = p0[0];
#pragma unroll
  for (int r = 1; r < 16; ++r) pmax = fmaxf(pmax, p0[r]);
#pragma unroll
  for (int r = 0; r < 16; ++r) pmax = fmaxf(pmax, p1[r]);
  { auto rr = __builtin_amdgcn_permlane32_swap(__float_as_uint(pmax), __float_as_uint(pmax), false, false);
    pmax = fmaxf(__uint_as_float(rr[0]), __uint_as_float(rr[1])); }
  if (__builtin_expect(__all(pmax - m_reg <= THRL), 1)) { mn = m_reg; alpha = 1.f; }
  else { mn = fmaxf(m_reg, pmax); alpha = __builtin_amdgcn_exp2f(m_reg - mn); m_reg = mn; }
#pragma unroll
  for (int r = 0; r < 16; ++r) p0[r] = p0[r] - mn;
#pragma unroll
  for (int r = 0; r < 16; ++r) p1[r] = p1[r] - mn;
#pragma unroll
  for (int r = 0; r < 16; ++r) p0[r] = __builtin_amdgcn_exp2f(p0[r]);
}
__device__ __forceinline__ void finishSM(f32x16& p0, f32x16& p1, float alpha, float& l_reg, bf16x8& pa0, bf16x8& pa1, bf16x8& pa2, bf16x8& pa3) {
#pragma unroll
  for (int r = 0; r < 16; ++r) p1[r] = __builtin_amdgcn_exp2f(p1[r]);
  float ps = 0;
#pragma unroll
  for (int r = 0; r < 16; ++r) ps += p0[r];
#pragma unroll
  for (int r = 0; r < 16; ++r) ps += p1[r];
  { auto rr = __builtin_amdgcn_permlane32_swap(__float_as_uint(ps), __float_as_uint(ps), false, false);
    ps = __uint_as_float(rr[0]) + __uint_as_float(rr[1]); }
  l_reg = l_reg * alpha + ps;
#define DA_PK4(P, BASE, OUT) do { unsigned a0 = cvtpk(P[BASE + 0], P[BASE + 1]), a1 = cvtpk(P[BASE + 2], P[BASE + 3]);   \
    unsigned b0 = cvtpk(P[BASE + 4], P[BASE + 5]), b1 = cvtpk(P[BASE + 6], P[BASE + 7]);                              \
    auto r0 = __builtin_amdgcn_permlane32_swap(a0, b0, false, false); auto r1 = __builtin_amdgcn_permlane32_swap(a1, b1, false, false); \
    u32x4 w = {r0[0], r1[0], r0[1], r1[1]}; OUT = __builtin_bit_cast(bf16x8, w); } while (0)
  DA_PK4(p0, 0, pa0); DA_PK4(p0, 8, pa1); DA_PK4(p1, 0, pa2); DA_PK4(p1, 8, pa3);
#undef DA_PK4
}
__device__ __forceinline__ void qkt(f32x16& p0, f32x16& p1, const LAS char* Ks, const bf16x8* qr, int r32, int hi, int mb) {
  p0 = f32x16{}; p1 = f32x16{};
#pragma unroll
  for (int d0 = 0; d0 < 4; ++d0) { const int cb = mb + (d0 * 16 + hi * 8) * 2;
    const bf16x8 b0 = *(const LAS bf16x8*)(Ks + DA_KSWZ(r32, cb));
    const bf16x8 b1 = *(const LAS bf16x8*)(Ks + DA_KSWZ(32 + r32, cb));
    p0 = __builtin_amdgcn_mfma_f32_32x32x16_bf16(b0, qr[d0], p0, 0, 0, 0);
    p1 = __builtin_amdgcn_mfma_f32_32x32x16_bf16(b1, qr[d0], p1, 0, 0, 0); }
}
__device__ __forceinline__ int v_st(int k, int c) { const int kk = (k & ~0xC) | ((k & 4) << 1) | ((k & 8) >> 1); return ((kk >> 3) * 4 + (c >> 5)) * 512 + ((kk & 7) * 32 + (c & 31)) * 2; }
__device__ __forceinline__ int v_rd_base(int lane) { return ((lane & 3) << 3) | (((lane >> 2) & 3) << 6) | (((lane >> 4) & 1) << 5) | (((lane >> 5) & 1) << 8); }
constexpr int v_rd_off(int d0, int ks, int half) { return d0 * 512 + ks * 4096 + half * 2048; }
template <int OFF> __device__ __forceinline__ s16x4 tr_read(int vb) { s16x4 r; asm volatile("ds_read_b64_tr_b16 %0, %1 offset:%2" : "=&v"(r) : "v"(vb), "i"(OFF) : "memory"); return r; }
template <int D0> __device__ __forceinline__ void pv_one(f32x16& od, int vb, bf16x8 pa0, bf16x8 pa1, bf16x8 pa2, bf16x8 pa3) {
  const s16x4 l0 = tr_read<v_rd_off(D0, 0, 0)>(vb), h0 = tr_read<v_rd_off(D0, 0, 1)>(vb), l1 = tr_read<v_rd_off(D0, 1, 0)>(vb), h1 = tr_read<v_rd_off(D0, 1, 1)>(vb);
  const s16x4 l2 = tr_read<v_rd_off(D0, 2, 0)>(vb), h2 = tr_read<v_rd_off(D0, 2, 1)>(vb), l3 = tr_read<v_rd_off(D0, 3, 0)>(vb), h3 = tr_read<v_rd_off(D0, 3, 1)>(vb);
  asm volatile("s_waitcnt lgkmcnt(0)" ::: "memory"); DA_SBAR();
#define DA_PK(L, H) (bf16x8){L[0], L[1], L[2], L[3], H[0], H[1], H[2], H[3]}
  od = __builtin_amdgcn_mfma_f32_32x32x16_bf16(pa0, DA_PK(l0, h0), od, 0, 0, 0);
  od = __builtin_amdgcn_mfma_f32_32x32x16_bf16(pa1, DA_PK(l1, h1), od, 0, 0, 0);
  od = __builtin_amdgcn_mfma_f32_32x32x16_bf16(pa2, DA_PK(l2, h2), od, 0, 0, 0);
  od = __builtin_amdgcn_mfma_f32_32x32x16_bf16(pa3, DA_PK(l3, h3), od, 0, 0, 0);
#undef DA_PK
}
__device__ __forceinline__ void pv_d0(f32x16* o, int vb, bf16x8 pa0, bf16x8 pa1, bf16x8 pa2, bf16x8 pa3) {
  pv_one<0>(o[0], vb, pa0, pa1, pa2, pa3); pv_one<1>(o[1], vb, pa0, pa1, pa2, pa3); pv_one<2>(o[2], vb, pa0, pa1, pa2, pa3); pv_one<3>(o[3], vb, pa0, pa1, pa2, pa3);
}
__device__ __forceinline__ void attn_unit(const bf16* __restrict__ Qb, const bf16* __restrict__ Kh, const bf16* __restrict__ Vh, bf16* __restrict__ Ob, int ldo, int seq,
                                          LAS unsigned char* lds, unsigned lds0, float lam, const float (&gs)[4]) {
  const int tid = threadIdx.x, wid = __builtin_amdgcn_readfirstlane(tid >> 6), lane = tid & 63, r32 = lane & 31, hi = lane >> 5, map = wid >> 2, rg = wid & 3, mb = map * 128;
  LAS char* V_lds = (LAS char*)lds; LAS char* K_lds = (LAS char*)lds + 2 * SHM_V;
  LAS float* ws = (LAS float*)(lds + 2 * SHM_V + 2 * SHM_K) + wid * 64; LAS float* li_l = ws; LAS float* al_l = ws + 32;
  float m_reg = -1e30f, l_reg = 0; f32x16 o[4] = {}; bf16x8 qr[4];
  const bf16* Qw = Qb + (long)(rg * QBLK + r32) * 512 + map * 64 + hi * 8;
#pragma unroll
  for (int d0 = 0; d0 < 4; ++d0) qr[d0] = *(const bf16x8*)(Qw + d0 * 16);
  const int sr = tid >> 4, sc = (tid & 15) * 8, vst0 = v_st(sr, sc), vst1 = v_st(32 + sr, sc);
  const int vb0 = (int)lds0 + v_rd_base(lane);
  struct { bf16x8 vs0, vs1, ks0, ks1; } sr_[2];
#define DA_SLOAD(i, k0) do { sr_[i].vs0 = *(const bf16x8*)(&Vh[(long)((k0) + sr) * LDK + sc]); sr_[i].vs1 = *(const bf16x8*)(&Vh[(long)((k0) + 32 + sr) * LDK + sc]); \
    sr_[i].ks0 = *(const bf16x8*)(&Kh[(long)((k0) + sr) * LDK + sc]); sr_[i].ks1 = *(const bf16x8*)(&Kh[(long)((k0) + 32 + sr) * LDK + sc]); } while (0)
#define DA_SWRITE(b, i) do { *(LAS bf16x8*)(V_lds + (b) * SHM_V + vst0) = sr_[i].vs0; *(LAS bf16x8*)(V_lds + (b) * SHM_V + vst1) = sr_[i].vs1; const int kc = sc * 2; \
    *(LAS bf16x8*)(K_lds + (b) * SHM_K + DA_KSWZ(sr, kc)) = sr_[i].ks0; *(LAS bf16x8*)(K_lds + (b) * SHM_K + DA_KSWZ(32 + sr, kc)) = sr_[i].ks1; } while (0)
#define DA_SWAIT() asm volatile("s_waitcnt vmcnt(4)" ::: "memory")
#define DA_RESC(a) do { if (__any((a) < 1.f)) { if (hi == 0) al_l[r32] = (a); asm volatile("s_waitcnt lgkmcnt(0)" ::: "memory"); \
    _Pragma("unroll") for (int d = 0; d < 4; ++d) _Pragma("unroll") for (int r = 0; r < 16; ++r) o[d][r] *= al_l[crow(r, hi)]; } } while (0)
  f32x16 pA0, pA1, pB0, pB1; float mnA, mnB, alA, alB; bf16x8 pa0, pa1, pa2, pa3; const int NT = seq / KVBLK;
  constexpr int SE = 0, SO = 1;
  DA_SLOAD(SE, 0); asm volatile("s_waitcnt vmcnt(0)" ::: "memory"); DA_SWRITE(0, SE); __syncthreads();
  qkt(pA0, pA1, K_lds, qr, r32, hi, mb); partialSM(pA0, pA1, m_reg, mnA, alA);
  DA_SLOAD(SO, KVBLK); if (2 < NT) DA_SLOAD(SE, 2 * KVBLK);
  DA_SWAIT(); DA_SWRITE(1, SO); __syncthreads();
  for (int j = 1; j + 1 < NT; j += 2) {
    DA_SBAR(); qkt(pB0, pB1, K_lds + SHM_K, qr, r32, hi, mb);
    finishSM(pA0, pA1, alA, l_reg, pa0, pa1, pa2, pa3); DA_SBAR();
    DA_SLOAD(SO, (j + 2) * KVBLK); DA_SBAR();
    pv_d0(o, vb0, pa0, pa1, pa2, pa3); partialSM(pB0, pB1, m_reg, mnB, alB);
    __syncthreads(); DA_SWAIT(); DA_SWRITE(0, SE);
    DA_RESC(alB); __syncthreads();
    DA_SBAR(); qkt(pA0, pA1, K_lds, qr, r32, hi, mb);
    finishSM(pB0, pB1, alB, l_reg, pa0, pa1, pa2, pa3); DA_SBAR();
    if (j + 3 < NT) DA_SLOAD(SE, (j + 3) * KVBLK); DA_SBAR();
    pv_d0(o, vb0 + SHM_V, pa0, pa1, pa2, pa3); partialSM(pA0, pA1, m_reg, mnA, alA);
    __syncthreads(); DA_SWAIT(); DA_SWRITE(1, SO);
    DA_RESC(alA); __syncthreads();
  }
  DA_SBAR(); qkt(pB0, pB1, K_lds + SHM_K, qr, r32, hi, mb);
  finishSM(pA0, pA1, alA, l_reg, pa0, pa1, pa2, pa3); DA_SBAR();
  pv_d0(o, vb0, pa0, pa1, pa2, pa3); partialSM(pB0, pB1, m_reg, mnB, alB);
  __syncthreads(); DA_RESC(alB);
  finishSM(pB0, pB1, alB, l_reg, pa0, pa1, pa2, pa3); DA_SBAR();
  pv_d0(o, vb0 + SHM_V, pa0, pa1, pa2, pa3);
  if (hi == 0) li_l[r32] = l_reg; asm volatile("s_waitcnt lgkmcnt(0)" ::: "memory");
  float rli[16];
#pragma unroll
  for (int r = 0; r < 16; ++r) rli[r] = __builtin_amdgcn_rcpf(li_l[crow(r, hi)]);
  asm volatile("s_waitcnt vmcnt(0)" ::: "memory");
  __syncthreads();
  LAS float* xch = (LAS float*)lds + rg * 4096 + lane;
  if (map == 1) {
#pragma unroll
    for (int d0 = 0; d0 < 4; ++d0)
#pragma unroll
      for (int r = 0; r < 16; ++r) xch[(d0 * 16 + r) * 64] = o[d0][r] * (rli[r] * lam);
  }
  asm volatile("s_waitcnt lgkmcnt(0)" ::: "memory");
  __syncthreads();
  if (map == 0) {
    float ss[16];
#pragma unroll
    for (int r = 0; r < 16; ++r) ss[r] = 0.f;
#pragma unroll
    for (int d0 = 0; d0 < 4; ++d0)
#pragma unroll
      for (int r = 0; r < 16; ++r) { const float v = o[d0][r] * rli[r] - xch[(d0 * 16 + r) * 64]; o[d0][r] = v; ss[r] += v * v; }
#pragma unroll
    for (int r = 0; r < 16; ++r) { float s = ss[r]; s += __shfl_xor(s, 1); s += __shfl_xor(s, 2); s += __shfl_xor(s, 4); s += __shfl_xor(s, 8); s += __shfl_xor(s, 16);
      ss[r] = __builtin_amdgcn_rsqf(s * (1.f / 128.f) + 1e-6f); }
    bf16* Ow = Ob + (long)(rg * QBLK) * ldo + r32;
#pragma unroll
    for (int r = 0; r < 16; ++r) { const int orow = crow(r, hi);
#pragma unroll
      for (int d0 = 0; d0 < 4; ++d0) { const unsigned w = cvtpk(o[d0][r] * ss[r] * gs[d0], 0.f); Ow[(long)orow * ldo + d0 * 32] = (bf16)(w & 0xffffu); } }
  }
  asm volatile("s_waitcnt lgkmcnt(0)" ::: "memory");
  __syncthreads();
#undef DA_SLOAD
#undef DA_SWRITE
#undef DA_SWAIT
#undef DA_RESC
}
#undef DA_KSWZ
#undef DA_SBAR
}
namespace fft {
using bf16x8 = __attribute__((ext_vector_type(8))) short;
using f32x4v = __attribute__((ext_vector_type(4))) float;
using u32x4 = __attribute__((ext_vector_type(4))) unsigned;
constexpr int XROW = 272;
constexpr int LDS_FFT = 4 * 64 * XROW;
__device__ __forceinline__ unsigned cvtpk(float lo, float hi) { typedef float f32x2_t __attribute__((ext_vector_type(2))); typedef __bf16 bf16x2_t __attribute__((ext_vector_type(2))); const f32x2_t v = {lo, hi}; return __builtin_bit_cast(unsigned, __builtin_convertvector(v, bf16x2_t)); }
__device__ __forceinline__ void fft_unit(const bf16* __restrict__ xg, bf16* __restrict__ out, int ldo, const bf16* __restrict__ F1T, const float2* __restrict__ TW, const bf16* __restrict__ F2P, LAS unsigned char* lds) {
  const int tid = threadIdx.x, lane = tid & 63, wave = __builtin_amdgcn_readfirstlane(tid >> 6), l16 = lane & 15, quad = lane >> 4;
#pragma unroll
  for (int it = 0; it < 8; ++it) { const int p = it * 512 + tid, n = 2 * p, n1 = n >> 6, n2 = n & 63;
    const uint4 v = ((const uint4*)xg)[p];
    LAS unsigned short* b0 = (LAS unsigned short*)(lds + n2 * XROW + n1 * 2);
    b0[(0 * 64) * (XROW / 2)] = (unsigned short)(v.x & 0xffffu); b0[(1 * 64) * (XROW / 2)] = (unsigned short)(v.x >> 16);
    b0[(2 * 64) * (XROW / 2)] = (unsigned short)(v.y & 0xffffu); b0[(3 * 64) * (XROW / 2)] = (unsigned short)(v.y >> 16);
    b0[(0 * 64 + 1) * (XROW / 2)] = (unsigned short)(v.z & 0xffffu); b0[(1 * 64 + 1) * (XROW / 2)] = (unsigned short)(v.z >> 16);
    b0[(2 * 64 + 1) * (XROW / 2)] = (unsigned short)(v.w & 0xffffu); b0[(3 * 64 + 1) * (XROW / 2)] = (unsigned short)(v.w >> 16); }
  bf16x8 f1[2][4]; float2 tw[4][4];
#pragma unroll
  for (int part = 0; part < 2; ++part)
#pragma unroll
    for (int s = 0; s < 4; ++s) f1[part][s] = *(const bf16x8*)(F1T + ((size_t)(part * 128 + 16 * wave + l16) * 128 + 32 * s + 8 * quad));
#pragma unroll
  for (int t = 0; t < 4; ++t)
#pragma unroll
    for (int j = 0; j < 4; ++j) tw[t][j] = TW[(16 * t + 4 * quad + j) * 128 + 16 * wave + l16];
  asm volatile("s_waitcnt lgkmcnt(0)" ::: "memory");
  __syncthreads();
  bf16x8 A2[4][2][2];
#pragma unroll
  for (int c = 0; c < 4; ++c) {
    f32x4v acc[4][2];
#pragma unroll
    for (int t = 0; t < 4; ++t) { acc[t][0] = (f32x4v){0.f, 0.f, 0.f, 0.f}; acc[t][1] = (f32x4v){0.f, 0.f, 0.f, 0.f}; }
#pragma unroll
    for (int t = 0; t < 4; ++t)
#pragma unroll
      for (int s = 0; s < 4; ++s) { const bf16x8 a = *(const LAS bf16x8*)(lds + (c * 64 + 16 * t + l16) * XROW + (32 * s + 8 * quad) * 2);
        acc[t][0] = __builtin_amdgcn_mfma_f32_16x16x32_bf16(a, f1[0][s], acc[t][0], 0, 0, 0);
        acc[t][1] = __builtin_amdgcn_mfma_f32_16x16x32_bf16(a, f1[1][s], acc[t][1], 0, 0, 0); }
    f32x4v pr[4], pi[4];
#pragma unroll
    for (int t = 0; t < 4; ++t)
#pragma unroll
      for (int j = 0; j < 4; ++j) { const float tr = acc[t][0][j], ti = acc[t][1][j]; const float2 w = tw[t][j]; pr[t][j] = tr * w.x - ti * w.y; pi[t][j] = tr * w.y + ti * w.x; }
#pragma unroll
    for (int sp = 0; sp < 2; ++sp) {
      u32x4 wr_ = {cvtpk(pr[2 * sp][0], pr[2 * sp][1]), cvtpk(pr[2 * sp][2], pr[2 * sp][3]), cvtpk(pr[2 * sp + 1][0], pr[2 * sp + 1][1]), cvtpk(pr[2 * sp + 1][2], pr[2 * sp + 1][3])};
      u32x4 wi_ = {cvtpk(pi[2 * sp][0], pi[2 * sp][1]), cvtpk(pi[2 * sp][2], pi[2 * sp][3]), cvtpk(pi[2 * sp + 1][0], pi[2 * sp + 1][1]), cvtpk(pi[2 * sp + 1][2], pi[2 * sp + 1][3])};
      A2[c][0][sp] = __builtin_bit_cast(bf16x8, wr_); A2[c][1][sp] = __builtin_bit_cast(bf16x8, wi_); }
  }
#pragma unroll
  for (int v = 0; v < 4; ++v) {
    bf16x8 bc[2], bs[2], bn[2];
#pragma unroll
    for (int sp = 0; sp < 2; ++sp) { const size_t o = (size_t)(16 * v + l16) * 64 + sp * 32 + quad * 8;
      bc[sp] = *(const bf16x8*)(F2P + o); bs[sp] = *(const bf16x8*)(F2P + 4096 + o); bn[sp] = *(const bf16x8*)(F2P + 8192 + o); }
    f32x4v dr[4], di[4];
#pragma unroll
    for (int c = 0; c < 4; ++c) { dr[c] = (f32x4v){0.f, 0.f, 0.f, 0.f}; di[c] = (f32x4v){0.f, 0.f, 0.f, 0.f};
#pragma unroll
      for (int sp = 0; sp < 2; ++sp) {
        dr[c] = __builtin_amdgcn_mfma_f32_16x16x32_bf16(A2[c][0][sp], bc[sp], dr[c], 0, 0, 0);
        dr[c] = __builtin_amdgcn_mfma_f32_16x16x32_bf16(A2[c][1][sp], bs[sp], dr[c], 0, 0, 0);
        di[c] = __builtin_amdgcn_mfma_f32_16x16x32_bf16(A2[c][0][sp], bn[sp], di[c], 0, 0, 0);
        di[c] = __builtin_amdgcn_mfma_f32_16x16x32_bf16(A2[c][1][sp], bc[sp], di[c], 0, 0, 0); } }
#pragma unroll
    for (int j = 0; j < 4; ++j) { const int tok = 16 * wave + 4 * quad + j + 128 * (16 * v + l16);
      u32x4 w = {cvtpk(dr[0][j], di[0][j]), cvtpk(dr[1][j], di[1][j]), cvtpk(dr[2][j], di[2][j]), cvtpk(dr[3][j], di[3][j])};
      *(u32x4*)(out + (size_t)tok * ldo) = w; }
  }
  __syncthreads();
}
}
constexpr int NWAVES = 8;
constexpr int RING_OFF = 0, RING_BYTES = 131072;
constexpr int LDSX_OFF = 163840 - 8192;
constexpr int MISC_OFF = LDSX_OFF, TB_OFF = LDSX_OFF + 512, TOKS_OFF = LDSX_OFF + 1024;
constexpr int LDS_BYTES = 163840;
static_assert(TOKS_OFF + 4 * 256 * 4 <= LDS_BYTES, "LDS map");
constexpr int CW_BAR = 4096;
namespace thin {
typedef float f32x4 __attribute__((ext_vector_type(4)));
typedef float f32x2 __attribute__((ext_vector_type(2)));
typedef unsigned u32x4 __attribute__((ext_vector_type(4)));
typedef unsigned u32x2 __attribute__((ext_vector_type(2)));
typedef short bf16x8 __attribute__((ext_vector_type(8)));
__device__ __forceinline__ unsigned pk2(float lo, float hi) { typedef float f32x2_t __attribute__((ext_vector_type(2))); typedef __bf16 bf16x2_t __attribute__((ext_vector_type(2))); const f32x2_t v = {lo, hi}; return __builtin_bit_cast(unsigned, __builtin_convertvector(v, bf16x2_t)); }
__device__ __forceinline__ float wave_sum(float v) {
#pragma unroll
    for (int o = 1; o < 64; o <<= 1) v += __shfl_xor(v, o);
    return v;
}
__device__ __forceinline__ void transpose_item(const float* W, int N, bf16* WT, int ldo, int mode, LAS float* scr, int item, int lane) {
    const int nblk = N / 32, kb = item / nblk, nb = item % nblk, k0 = 64 * kb, n0 = 32 * nb;
#pragma unroll 8
    for (int i = 0; i < 32; ++i) { const int kk = 2 * i + (lane >> 5); scr[kk * 33 + (lane & 31)] = W[(size_t)(k0 + kk) * N + n0 + (lane & 31)]; }
    LDS_WAIT(); asm volatile("" ::: "memory");
    const int c = lane & 7;
#pragma unroll
    for (int j = 0; j < 4; ++j) { const int nl = (lane >> 3) + 8 * j, n = n0 + nl; const LAS float* s = scr + (8 * c) * 33 + nl;
        const int row = mode == 0 ? n : ((n >> 4) * 32 + (n & 15) + (mode == 2 ? 16 : 0));
        u32x4 o; o.x = pk2(s[0 * 33], s[1 * 33]); o.y = pk2(s[2 * 33], s[3 * 33]); o.z = pk2(s[4 * 33], s[5 * 33]); o.w = pk2(s[6 * 33], s[7 * 33]);
        *(u32x4*)(WT + (size_t)row * ldo + k0 + 8 * c) = o; }
    LDS_WAIT(); asm volatile("" ::: "memory");
}
struct P0Args { const float *c, *cctx, *w_ada, *b_ada, *w_in, *w_out, *w_gate, *w_up, *w_down, *wfour, *wrg, *wre; float *modv, *rope, *cs; bf16 *f1t; float2* tw; bf16 *f2p, *wrf, *win_t, *wout_t, *wgu, *wd; };
__device__ __forceinline__ void p0_prologue(const P0Args& a, LAS unsigned char* lds, int bx, int G, int tid, int lane, int wave) {
    for (int u = bx; u < 192; u += G) {
        const int col0 = u * 32, c4 = tid & 7, kk = tid >> 3;
        f32x4 acc[3] = {};
#pragma unroll 4
        for (int i = 0; i < 16; ++i) { const int k = kk + 64 * i; const f32x4 w = *(const f32x4*)(a.w_ada + (size_t)k * 6144 + col0 + 4 * c4);
#pragma unroll
            for (int v = 0; v < 3; ++v) { const float s = v < 2 ? a.c[v * D + k] : a.cctx[k]; acc[v] += (s / (1.f + expf(-s))) * w; } }
        LAS f32x4* red = (LAS f32x4*)lds;
#pragma unroll
        for (int v = 0; v < 3; ++v) red[(kk * 3 + v) * 8 + c4] = acc[v];
        __syncthreads();
        if (tid < 96) { const int v = tid >> 5, col = tid & 31; float s = a.b_ada[col0 + col];
            for (int q = 0; q < 64; ++q) s += ((LAS float*)lds)[((q * 3 + v) * 8) * 4 + col];
            a.modv[v * 6144 + col0 + col] = s; }
        __syncthreads();
    }
    const int gt = bx * 512 + tid, NT = G * 512;
    for (int t = gt; t < 2048; t += NT) { const int pos = t >> 4, i = t & 15; const float inv = powf(10000.f, -(float)(2 * i) / 32.f), ang = (float)pos * inv; a.rope[t] = cosf(ang); a.rope[2048 + t] = sinf(ang); }
    for (int t = gt; t < 32768; t += NT) {
        { const int part = t >> 14, k1 = (t >> 7) & 127, n1 = t & 127; const float x = (float)((k1 * n1) & 127) / 64.f; a.f1t[t] = (bf16)(pk2(part ? -sinpif(x) : cospif(x), 0.f) & 0xffffu); }
        if (t < 8192) { const int n2 = t >> 7, k1 = t & 127; const float x = (float)(n2 * k1) / 4096.f; a.tw[t] = make_float2(cospif(x), -sinpif(x)); }
        if (t < 12288) { const int tab = t >> 12, k2 = (t >> 6) & 63, pos = t & 63, sp = pos >> 5, quad = (pos >> 3) & 3, jj = pos & 7;
            const int n2 = 32 * sp + (jj < 4 ? 4 * quad + jj : 16 + 4 * quad + (jj - 4)); const float x = (float)((n2 * k2) & 63) / 32.f;
            a.f2p[t] = (bf16)(pk2(tab == 0 ? cospif(x) : (tab == 1 ? sinpif(x) : -sinpif(x)), 0.f) & 0xffffu); } }
    for (int t = gt; t < 32 * 3 * 2 * 64 * 8; t += NT) { const int j = t & 7, ln = (t >> 3) & 63, hl = (t >> 9) & 1, nt = (t >> 10) % 3, s = t / 3072;
        const int k = 32 * s + 8 * (ln >> 4) + j, e = 16 * nt + (ln & 15);
        const float w = e < 4 ? a.wrg[k * 4 + e] : (e < 36 ? a.wre[k * 32 + (e - 4)] : 0.f);
        const unsigned hi = pk2(w, 0.f) & 0xffffu; const float lo = w - __uint_as_float(hi << 16);
        a.wrf[t] = (bf16)(hl ? (pk2(lo, 0.f) & 0xffffu) : hi); }
    { LAS float* tr = (LAS float*)lds;
      if (tid < 128) { tr[tid] = cospif((float)tid / 64.f); tr[128 + tid] = sinpif((float)tid / 64.f); }
      __syncthreads();
      for (int t = gt; t < 131072; t += NT) { const int d = t & 127, c = (t >> 7) & 127, part = (t >> 14) & 1, g = t >> 15; float acc = 0.f;
#pragma unroll 8
          for (int kap = 0; kap < 128; ++kap) acc += tr[part * 128 + ((c * kap) & 127)] * a.wfour[((size_t)g * 128 + kap) * 128 + d];
          a.cs[t] = acc * (1.0f / 1024.0f); }
      __syncthreads(); }
    { LAS float* scr = (LAS float*)(lds + wave * 16384);
      const int gw = bx * 8 + wave, NGW = G * 8;
      constexpr int I_IN = 16 * 64, I_OUT = 8 * 32, I_G = 16 * 16, I_D = 8 * 32, NITEMS = I_IN + I_OUT + NEXP * (2 * I_G + I_D);
      for (int it = gw; it < NITEMS; it += NGW) { int r = it;
          if (r < I_IN) { transpose_item(a.w_in, 2048, a.win_t, D, 0, scr, r, lane); continue; } r -= I_IN;
          if (r < I_OUT) { transpose_item(a.w_out, D, a.wout_t, KO, 0, scr, r, lane); continue; } r -= I_OUT;
          const int e = r / (2 * I_G + I_D); r -= e * (2 * I_G + I_D);
          if (r < I_G) { transpose_item(a.w_gate + (size_t)e * D * DE, DE, a.wgu + (size_t)e * 1024 * D, D, 1, scr, r, lane); continue; } r -= I_G;
          if (r < I_G) { transpose_item(a.w_up + (size_t)e * D * DE, DE, a.wgu + (size_t)e * 1024 * D, D, 2, scr, r, lane); continue; } r -= I_G;
          transpose_item(a.w_down + (size_t)e * DE * D, D, a.wd + (size_t)e * 1024 * DE, DE, 0, scr, r, lane); } }
}
__device__ __forceinline__ void p1_norms(const float* x, const float* ctx, const float* gmix, const float* modv, bf16* hl, const float* cs, const float* w_out, bf16* wout_t,
                                         LAS unsigned char* lds, int bx, int G, int tid, int lane, int wave) {
    for (int u = bx; u < 128; u += G) {
        const int g = u >> 5, kb = u & 31; LAS float* csl = (LAS float*)lds;
        for (int t = tid; t < 1024; t += 512) { const int i = t >> 7, d = t & 127; csl[t] = cs[(((size_t)g * 2 + (i & 1)) * 128 + 4 * kb + (i >> 1)) * 128 + d]; }
        __syncthreads();
        f32x2 acc[8] = {};
#pragma unroll 4
        for (int d = 0; d < 128; ++d) { const f32x2 w2 = *(const f32x2*)(w_out + (size_t)(512 + g * 128 + d) * D + 2 * tid);
#pragma unroll
            for (int i = 0; i < 8; ++i) acc[i] += csl[i * 128 + d] * w2; }
#pragma unroll
        for (int h = 0; h < 2; ++h) { u32x4 o; o.x = pk2(acc[0][h], acc[1][h]); o.y = pk2(acc[2][h], acc[3][h]); o.z = pk2(acc[4][h], acc[5][h]); o.w = pk2(acc[6][h], acc[7][h]);
            *(u32x4*)(wout_t + (size_t)(2 * tid + h) * KO + 512 + g * 256 + 8 * kb) = o; }
        __syncthreads();
    }
    const int gw = bx * 8 + wave, NGW = G * 8;
    for (int row = gw; row < M + 512; row += NGW) {
        const float* src = row < M ? x + (size_t)row * D : ctx + (size_t)(row - M) * D;
        const float* mv = modv + (row < M ? (row >> 13) : 2) * 6144;
        f32x4 v[4]; float ss = 0.f;
#pragma unroll
        for (int j = 0; j < 4; ++j) { v[j] = ((const f32x4*)src)[lane + 64 * j]; ss += (v[j].x * v[j].x + v[j].y * v[j].y) + (v[j].z * v[j].z + v[j].w * v[j].w); }
        const float rs = rsqrtf(wave_sum(ss) * (1.f / D) + EPS);
#pragma unroll
        for (int j = 0; j < 4; ++j) { const int k = 4 * lane + 256 * j; const f32x4 gv = *(const f32x4*)(gmix + k), sh = *(const f32x4*)(mv + k), sc = *(const f32x4*)(mv + 1024 + k);
            const f32x4 o = (v[j] * rs * gv) * (1.f + sc) + sh; u32x2 w; w.x = pk2(o.x, o.y); w.y = pk2(o.z, o.w);
            *(u32x2*)(hl + (size_t)row * D + k) = w; }
    }
}
__device__ __forceinline__ void ctx_proj(const bf16* hc, const bf16* win_t, bf16* Kb, bf16* Vb, int bx, int G, int lane, int wave) {
    const int l16 = lane & 15, quad = lane >> 4;
    for (int u = bx; u < 256; u += G) {
        const int row = 32 * (u >> 4) + 16 * (wave >> 2) + l16, col = 64 * (u & 15) + 16 * (wave & 3) + l16;
        const bf16* ap = hc + (size_t)row * D + 8 * quad; const bf16* bp = win_t + (size_t)(512 + col) * D + 8 * quad;
        f32x4 acc = {0.f, 0.f, 0.f, 0.f};
#pragma unroll 8
        for (int s = 0; s < 32; ++s) acc = __builtin_amdgcn_mfma_f32_16x16x32_bf16(*(const bf16x8*)(ap + 32 * s), *(const bf16x8*)(bp + 32 * s), acc, 0, 0, 0);
#pragma unroll
        for (int j = 0; j < 4; ++j) { const int r = 32 * (u >> 4) + 16 * (wave >> 2) + 4 * quad + j, b = r >> 8, jr = r & 255;
            bf16* dst = col < 512 ? Kb : Vb; dst[((size_t)b * KV + jr) * 512 + (col & 511)] = (bf16)(pk2(acc[j], 0.f) & 0xffffu); }
    }
}
__device__ __forceinline__ void p5_router(const float* xl, const float* ssq, const float* gffn, const float* modv, const bf16* wrf, const float* brg, const float* bre,
                                          bf16* h2, unsigned* cnt, int* tokof, int* expid, int* posb, float* gate, LAS unsigned char* lds, int bx, int G, int tid, int lane, int wave) {
    const int l16 = lane & 15, quad = lane >> 4, grp = wave & 3, kh = wave >> 2;
    LAS float* LG = (LAS float*)lds;
    LAS int* hist = (LAS int*)(lds + 32768); LAS int* base = hist + 32;
    for (int tbk = bx; tbk < M / 64; tbk += G) {
        const int token = tbk * 64 + 16 * grp + l16, b = token >> 13; const float* mv = modv + b * 6144;
        float tot = 0.f;
#pragma unroll
        for (int q = 0; q < 4; ++q) { const f32x4 p = *(const f32x4*)(ssq + (size_t)token * 16 + 4 * q); tot += (p.x + p.y) + (p.z + p.w); }
        const float rs = rsqrtf(tot * (1.f / D) + EPS);
        f32x4 acc[3] = {};
        if (tid < 32) hist[tid] = 0;
#pragma unroll 2
        for (int s = kh * 16; s < kh * 16 + 16; ++s) { const int k0 = 32 * s + 8 * quad; float hv[8];
#pragma unroll
            for (int q = 0; q < 2; ++q) { const f32x4 xv = *(const f32x4*)(xl + (size_t)token * D + k0 + 4 * q), gv = *(const f32x4*)(gffn + k0 + 4 * q), sc = *(const f32x4*)(mv + 4096 + k0 + 4 * q), sh = *(const f32x4*)(mv + 3072 + k0 + 4 * q);
                const f32x4 o = (xv * rs * gv) * (1.f + sc) + sh; hv[4 * q] = o.x; hv[4 * q + 1] = o.y; hv[4 * q + 2] = o.z; hv[4 * q + 3] = o.w; }
            u32x4 hi, lo;
#pragma unroll
            for (int q = 0; q < 4; ++q) { const unsigned w = pk2(hv[2 * q], hv[2 * q + 1]); hi[q] = w;
                lo[q] = pk2(hv[2 * q] - __uint_as_float(w << 16), hv[2 * q + 1] - __uint_as_float(w & 0xffff0000u)); }
            *(u32x4*)(h2 + (size_t)token * D + k0) = hi;
            const bf16x8 ah = __builtin_bit_cast(bf16x8, hi), al = __builtin_bit_cast(bf16x8, lo);
#pragma unroll
            for (int nt = 0; nt < 3; ++nt) { const bf16x8 bh = *(const bf16x8*)(wrf + ((size_t)((s * 3 + nt) * 2 + 0) * 64 + lane) * 8), bl = *(const bf16x8*)(wrf + ((size_t)((s * 3 + nt) * 2 + 1) * 64 + lane) * 8);
                acc[nt] = __builtin_amdgcn_mfma_f32_16x16x32_bf16(ah, bh, acc[nt], 0, 0, 0);
                acc[nt] = __builtin_amdgcn_mfma_f32_16x16x32_bf16(ah, bl, acc[nt], 0, 0, 0);
                acc[nt] = __builtin_amdgcn_mfma_f32_16x16x32_bf16(al, bh, acc[nt], 0, 0, 0); } }
#pragma unroll
        for (int nt = 0; nt < 3; ++nt)
#pragma unroll
            for (int j = 0; j < 4; ++j) LG[((kh * 4 + grp) * 16 + 4 * quad + j) * 48 + 16 * nt + l16] = acc[nt][j];
        __syncthreads();
        int ex0 = 0, ex1 = 0, lp0 = 0, lp1 = 0; float g0 = 0.f, g1 = 0.f;
        if (tid < 64) {
            const LAS float* p0 = LG + (size_t)tid * 48; const LAS float* p1 = LG + (size_t)(64 + tid) * 48; float lg[36];
#pragma unroll
            for (int e = 0; e < 36; ++e) lg[e] = p0[e] + p1[e] + (e < 4 ? brg[e] : bre[e - 4]);
            int grpi = 0; float gm = lg[0];
#pragma unroll
            for (int i = 1; i < 4; ++i) if (lg[i] > gm) { gm = lg[i]; grpi = i; }
            float se = 0.f;
#pragma unroll
            for (int i = 0; i < 4; ++i) se += expf(lg[i] - gm);
            const float pg = 1.f / se;
            float el[8];
#pragma unroll
            for (int i = 0; i < 8; ++i) el[i] = grpi == 0 ? lg[4 + i] : (grpi == 1 ? lg[12 + i] : (grpi == 2 ? lg[20 + i] : lg[28 + i]));
            int i0 = 0; float v0 = el[0];
#pragma unroll
            for (int i = 1; i < 8; ++i) if (el[i] > v0) { v0 = el[i]; i0 = i; }
            int i1 = -1; float v1 = -3.0e38f;
#pragma unroll
            for (int i = 0; i < 8; ++i) if (i != i0 && el[i] > v1) { v1 = el[i]; i1 = i; }
            const float e1 = expf(v1 - v0); g0 = pg / (1.f + e1); g1 = pg * e1 / (1.f + e1);
            ex0 = grpi * 8 + i0; ex1 = grpi * 8 + i1;
            lp0 = __hip_atomic_fetch_add(hist + ex0, 1, __ATOMIC_RELAXED, __HIP_MEMORY_SCOPE_WORKGROUP); lp1 = __hip_atomic_fetch_add(hist + ex1, 1, __ATOMIC_RELAXED, __HIP_MEMORY_SCOPE_WORKGROUP);
        }
        __syncthreads();
        if (tid < 32) { const int n = hist[tid]; base[tid] = n > 0 ? (int)atomicAdd(&cnt[tid * 64], (unsigned)n) : 0; }
        __syncthreads();
        if (tid < 64) { const int tk = tbk * 64 + tid, q0 = base[ex0] + lp0, q1 = base[ex1] + lp1;
            tokof[ex0 * 16384 + q0] = tk; tokof[ex1 * 16384 + q1] = tk;
            expid[tk * 2] = ex0; expid[tk * 2 + 1] = ex1; posb[tk * 2] = q0; posb[tk * 2 + 1] = q1; gate[tk * 2] = g0; gate[tk * 2 + 1] = g1; }
        __syncthreads();
    }
}
__device__ __forceinline__ void p8_final(const bf16* ybuf, const int* expid, const int* posb, const float* gate, const float* modv, const float* gfin, float* out, const LAS int* tb, int bx, int G, int lane, int wave) {
    const int gw = bx * 8 + wave, NGW = G * 8;
    for (int row = gw; row < M; row += NGW) {
        const int e0 = expid[row * 2], e1 = expid[row * 2 + 1];
        const bf16* y0 = ybuf + (size_t)(tb[e0] * 256 + posb[row * 2]) * D; const bf16* y1 = ybuf + (size_t)(tb[e1] * 256 + posb[row * 2 + 1]) * D;
        const float g0 = gate[row * 2], g1 = gate[row * 2 + 1]; const float* gt2 = modv + (row >> 13) * 6144 + 5120;
        f32x4 v[4]; float ss = 0.f;
#pragma unroll
        for (int j = 0; j < 4; ++j) { const int k = 4 * lane + 256 * j; const f32x4 xv = *(const f32x4*)(out + (size_t)row * D + k), gv = *(const f32x4*)(gt2 + k);
            const u32x2 a = *(const u32x2*)(y0 + k), c = *(const u32x2*)(y1 + k);
            f32x4 ya = {__uint_as_float(a.x << 16), __uint_as_float(a.x & 0xffff0000u), __uint_as_float(a.y << 16), __uint_as_float(a.y & 0xffff0000u)};
            f32x4 yc = {__uint_as_float(c.x << 16), __uint_as_float(c.x & 0xffff0000u), __uint_as_float(c.y << 16), __uint_as_float(c.y & 0xffff0000u)};
            v[j] = xv + gv * (g0 * ya + g1 * yc); ss += (v[j].x * v[j].x + v[j].y * v[j].y) + (v[j].z * v[j].z + v[j].w * v[j].w); }
        const float rs = rsqrtf(wave_sum(ss) * (1.f / D) + EPS);
#pragma unroll
        for (int j = 0; j < 4; ++j) { const int k = 4 * lane + 256 * j; *(f32x4*)(out + (size_t)row * D + k) = v[j] * rs * *(const f32x4*)(gfin + k); }
    }
}
}
struct Args { const float* in[24]; float* out; unsigned char* ws; int ph_lo, ph_hi, li, pad; };
__global__ void __launch_bounds__(NWAVES * 64, 2) mk_fwd(Args args) {
    extern __shared__ __attribute__((aligned(16))) unsigned char lds_raw[];
    LAS unsigned char* lds = (LAS unsigned char*)lds_raw;
    volatile LAS unsigned* MISC = (volatile LAS unsigned*)(lds + MISC_OFF);
    const int tid = threadIdx.x, lane = tid & 63, wave = __builtin_amdgcn_readfirstlane(tid >> 6);
    const int G = gridDim.x, bx = blockIdx.x;
    unsigned char* ws = args.ws;
    unsigned* ctl = (unsigned*)(ws + WS_CTL);
    if (tid < 32) MISC[tid] = 0u;
    __syncthreads();
    const int lo = args.ph_lo, hi = args.ph_hi;
    XcdBarrier bar; bar.bar = ctl + CW_BAR + args.li * XCD_BAR_WORDS; bar.x = 0; bar.st = nullptr;
    if (hi - lo > 1) bar = xcd_barrier_post(ctl + CW_BAR + args.li * XCD_BAR_WORDS, MISC + 8);
#ifndef PH_ENABLE
#define PH_ENABLE 0x1FF
#endif
#define IN(k) (((PH_ENABLE >> (k)) & 1) && lo <= (k) && (k) < hi)
#define SEAM(k) do { if (IN(k) && IN((k) + 1)) xcd_barrier(bar); } while (0)
    bf16* win_t = (bf16*)(ws + WS_WIN_T); bf16* wout_t = (bf16*)(ws + WS_WOUT_T); bf16* wgu = (bf16*)(ws + WS_WGU); bf16* wd = (bf16*)(ws + WS_WD);
    bf16* hl = (bf16*)(ws + WS_HL); bf16* amix = (bf16*)(ws + WS_AMIX); bf16* ybuf = (bf16*)(ws + WS_YBUF);
    bf16* Q = (bf16*)(ws + WS_Q); bf16* Kb = (bf16*)(ws + WS_K); bf16* Vb = (bf16*)(ws + WS_V); bf16* F = (bf16*)(ws + WS_F);
    bf16* h2 = (bf16*)(ws + WS_H2); bf16* hmid = (bf16*)(ws + WS_HMID);
    float* modv = (float*)(ws + WS_MOD); float* rope = (float*)(ws + WS_ROPE); float* ssq = (float*)(ws + WS_SSQ);
    float* xl = args.out;

    int* tokof = (int*)(ws + WS_TOKOF); int* expid = (int*)(ws + WS_RT); int* posb = expid + M * 2; float* gate = (float*)(posb + M * 2);
    unsigned* cnt = ctl + CW_CNT;
    if (IN(0)) {
        thin::P0Args a{args.in[1], args.in[3], args.in[4], args.in[5], args.in[8], args.in[15], args.in[20], args.in[21], args.in[22], args.in[14], args.in[16], args.in[18],
                       modv, rope, (float*)(ws + WS_CS), (bf16*)(ws + WS_F1T), (float2*)(ws + WS_TW), (bf16*)(ws + WS_F2P), (bf16*)(ws + WS_WRF), win_t, wout_t, wgu, wd};
        thin::p0_prologue(a, lds + RING_OFF, bx, G, tid, lane, wave);
    }
    SEAM(0);
    if (IN(1)) thin::p1_norms(args.in[0], args.in[2], args.in[6], modv, hl, (const float*)(ws + WS_CS), args.in[15], wout_t, lds + RING_OFF, bx, G, tid, lane, wave);
    SEAM(1);
    if (IN(2)) {
        thin::ctx_proj(hl + (size_t)M * D, win_t, Kb, Vb, bx, G, lane, wave);
        pg8::Gemm g{hl, win_t, M, 2048, D}; pg8::StaticOrder S; S.init(M, 2048, G, bx);
        pg8::EpiInProj E{Q, Kb, Vb, F, rope};
        pg8::gemm_phase<pg8::EpiInProj, pg8::StaticOrder, true, true>(lds + RING_OFF, g, S, E);
    }
    SEAM(2);
    if (IN(3)) {
        const float* lq1 = args.in[9]; const float* lk1 = args.in[10]; const float* lq2 = args.in[11]; const float* lk2 = args.in[12]; const float* gsub = args.in[13];
        float a1 = lq1[lane] * lk1[lane], a2 = lq2[lane] * lk2[lane];
#pragma unroll
        for (int o = 1; o < 64; o <<= 1) { a1 += __shfl_xor(a1, o); a2 += __shfl_xor(a2, o); }
        const float lam = expf(a1) - expf(a2) + 0.2f;
        float gs[4];
#pragma unroll
        for (int d0 = 0; d0 < 4; ++d0) gs[d0] = gsub[32 * d0 + (lane & 31)] * 0.8f;
        const unsigned lds0 = (unsigned)(uintptr_t)lds_raw + RING_OFF;
        if (!(args.pad & 1)) for (int u = bx; u < 512; u += G) { const int bh = u & 7, qb = u >> 3, b = bh >> 2, h = bh & 3;
            da::attn_unit(Q + ((size_t)b * S + qb * 128) * 512 + h * 128, Kb + (size_t)b * KV * 512 + h * 128, Vb + (size_t)b * KV * 512 + h * 128,
                          amix + ((size_t)b * S + qb * 128) * KO + h * 128, KO, KV, lds + RING_OFF, lds0, lam, gs); }
        if (!(args.pad & 2)) for (int u = bx; u < 256; u += G) { const int b = u >> 7, g = (u >> 5) & 3, cq = u & 31;
            fft::fft_unit(F + (size_t)u * S * 4, amix + (size_t)b * S * KO + 512 + g * 256 + cq * 8, KO, (const bf16*)(ws + WS_F1T), (const float2*)(ws + WS_TW), (const bf16*)(ws + WS_F2P), lds + RING_OFF); }
    }
    SEAM(3);
    if (IN(4)) {
        pg8::Gemm g{amix, wout_t, M, D, KO}; pg8::StaticOrder S; S.init(M, D, G, bx);
        pg8::EpiOut E{args.in[0], modv, xl, ssq};
        pg8::gemm_phase<pg8::EpiOut, pg8::StaticOrder, true, true>(lds + RING_OFF, g, S, E);
    }
    SEAM(4);
    if (IN(5)) thin::p5_router(xl, ssq, args.in[7], modv, (const bf16*)(ws + WS_WRF), args.in[17], args.in[19], h2, cnt, tokof, expid, posb, gate, lds + RING_OFF, bx, G, tid, lane, wave);
    SEAM(5);
    if (IN(6) || IN(7) || IN(8)) {
        LAS int* tb = (LAS int*)(lds + TB_OFF); LAS int* toks = (LAS int*)(lds + TOKS_OFF);
        if (tid == 0) { int a = 0; for (int e = 0; e < NEXP; ++e) { tb[e] = a; a += ((int)cnt[e * 64] + 255) >> 8; } tb[NEXP] = a; }
        __syncthreads();
        pg8::MoeOrder S{tb[NEXP] * 4, G, bx, tb, toks};
        if (IN(6)) {
            for (int i = 0; i < 4; ++i) { pg8::Unit u; if (!S.next(i, u)) break;
                const int e = u.pn >> 2, pos = (u.pm - tb[e]) * 256 + tid;
                if (tid < 256) toks[i * 256 + tid] = pos < (int)cnt[e * 64] ? tokof[e * 16384 + pos] : 0; }
            __syncthreads();
            pg8::Gemm g{h2, wgu, MAXSLOT, 1024, D};
            pg8::EpiGateUp E{hmid};
            pg8::gemm_phase<pg8::EpiGateUp, pg8::MoeOrder, true, true, true>(lds + RING_OFF, g, S, E);
        }
        SEAM(6);
        if (IN(7)) {
            pg8::Gemm g{hmid, wd, MAXSLOT, 1024, DE};
            pg8::EpiDown E{ybuf};
            pg8::gemm_phase<pg8::EpiDown, pg8::MoeOrder, true, true, false>(lds + RING_OFF, g, S, E);
        }
        SEAM(7);
        if (IN(8)) thin::p8_final(ybuf, expid, posb, gate, modv, args.in[23], args.out, tb, bx, G, lane, wave);
    }
#undef IN
#undef SEAM
}

#define ONE_LAUNCH 1
#ifndef OPT_MASK
#define OPT_MASK 0x3FF
#endif
static void launch_phases(const Args& base, int lo, int hi, int li, int grid, hipStream_t stream, int flags = 0) {
    Args a = base; a.ph_lo = lo; a.ph_hi = hi; a.li = li; a.pad = flags;
    hipLaunchKernelGGL(mk_fwd, dim3(grid), dim3(NWAVES * 64), LDS_BYTES, stream, a);
    const hipError_t le = hipPeekAtLastError();
    if (le != hipSuccess) fprintf(stderr, "kernel_launch: mk_fwd [%d,%d) failed: %s\n", lo, hi, hipGetErrorName(le));
}
extern "C" void kernel_launch(void* const* d_in, const int* in_sizes, int n_in, void* d_out, int out_size, void* d_ws, size_t ws_size, hipStream_t stream) {
    static int ok = 0; static int grid_g = 256;
    if (ok == 0) {
        if (n_in != 24 || in_sizes[0] != M * D || out_size != M * D || ws_size < WS_END) { fprintf(stderr, "kernel_launch: shape/ws mismatch n_in %d in0 %d out %d ws %zu (need %zu)\n", n_in, n_in > 0 ? in_sizes[0] : -1, out_size, ws_size, (size_t)WS_END); ok = -1; return; }
        hipFuncSetAttribute((const void*)k_attn, hipFuncAttributeMaxDynamicSharedMemorySize, (2 * KV + 128 + 8 + 256) * 4);
        hipFuncSetAttribute((const void*)k_fft, hipFuncAttributeMaxDynamicSharedMemorySize, 2 * 8192 * 4 + S * 4 * 2);
        if (hipFuncSetAttribute((const void*)mk_fwd, hipFuncAttributeMaxDynamicSharedMemorySize, LDS_BYTES) != hipSuccess) { fprintf(stderr, "kernel_launch: hipFuncSetAttribute(mk_fwd) failed\n"); ok = -1; return; }
        int dev = 0, cus = 0, per_cu = 0;
        hipGetDevice(&dev); hipDeviceGetAttribute(&cus, hipDeviceAttributeMultiprocessorCount, dev);
        hipOccupancyMaxActiveBlocksPerMultiprocessor(&per_cu, (const void*)mk_fwd, NWAVES * 64, LDS_BYTES);
        if (per_cu < 1 || cus != 256) fprintf(stderr, "kernel_launch: note: occupancy %d blocks/CU, %d CUs\n", per_cu, cus);
        (void)hipGetLastError();
        grid_g = cus;
        ok = 1;
    }
    if (ok < 0) return;
    const float* x = (const float*)d_in[0]; const float* c = (const float*)d_in[1]; const float* ctx = (const float*)d_in[2]; const float* cctx = (const float*)d_in[3];
    const float* w_ada = (const float*)d_in[4]; const float* b_ada = (const float*)d_in[5]; const float* gmix = (const float*)d_in[6]; const float* gffn = (const float*)d_in[7];
    const float* w_in = (const float*)d_in[8]; const float* lq1 = (const float*)d_in[9]; const float* lk1 = (const float*)d_in[10]; const float* lq2 = (const float*)d_in[11]; const float* lk2 = (const float*)d_in[12];
    const float* gsub = (const float*)d_in[13]; const float* wfour = (const float*)d_in[14]; const float* w_out = (const float*)d_in[15];
    const float* wrg = (const float*)d_in[16]; const float* brg = (const float*)d_in[17]; const float* wre = (const float*)d_in[18]; const float* bre = (const float*)d_in[19];
    const float* w_gate = (const float*)d_in[20]; const float* w_up = (const float*)d_in[21]; const float* w_down = (const float*)d_in[22]; const float* gfin = (const float*)d_in[23];
    unsigned char* ws = (unsigned char*)d_ws; float* out = (float*)d_out;
    unsigned* ctl = (unsigned*)(ws + WS_CTL); float* modv = (float*)(ws + WS_MOD); float* rope = (float*)(ws + WS_ROPE); float* cs = (float*)(ws + WS_CS);
    int* expid = (int*)(ws + WS_RT); int* posb = expid + M * 2; float* gate = (float*)(posb + M * 2);
    int* tokof = (int*)(ws + WS_TOKOF);
    bf16* win_t = (bf16*)(ws + WS_WIN_T); bf16* wout_t = (bf16*)(ws + WS_WOUT_T); bf16* wgu = (bf16*)(ws + WS_WGU); bf16* wd = (bf16*)(ws + WS_WD);
    bf16* hl = (bf16*)(ws + WS_HL); bf16* hc = (bf16*)(ws + WS_HC); bf16* amix = (bf16*)(ws + WS_AMIX); bf16* ybuf = (bf16*)(ws + WS_YBUF);
    bf16* Q = (bf16*)(ws + WS_Q); bf16* Kb = (bf16*)(ws + WS_K); bf16* Vb = (bf16*)(ws + WS_V); bf16* F = (bf16*)(ws + WS_F);
    bf16* h2 = (bf16*)(ws + WS_H2); bf16* hmid = (bf16*)(ws + WS_HMID);
    float* xl = out;
    Args base{}; for (int i = 0; i < 24; ++i) base.in[i] = (const float*)d_in[i]; base.out = out; base.ws = ws;
    hipMemsetAsync(ws + WS_CTL, 0, CTL_ZERO_BYTES, stream);
#if defined(ONE_LAUNCH)
    launch_phases(base, 0, 9, 0, grid_g, stream);
#else
    if (OPT_MASK & 1) launch_phases(base, 0, 1, 0, grid_g, stream);
    else {
    k_mod<<<dim3(6144 / 256, 3), 256, 0, stream>>>(c, cctx, w_ada, b_ada, modv);
    k_tables<<<8, 256, 0, stream>>>(rope);
    k_fft_tables<<<128, 256, 0, stream>>>((bf16*)(ws + WS_F1T), (float2*)(ws + WS_TW), (bf16*)(ws + WS_F2P));
    k_cvtT<<<dim3(D * 2048 / 256, 1), 256, 0, stream>>>(w_in, D, 2048, 0, win_t, D, 0, 0, 0);
    k_cvtT<<<dim3(512 * D / 256, 1), 256, 0, stream>>>(w_out, 512, D, 0, wout_t, KO, 0, 0, 0);
    k_cvtT<<<dim3(D * DE / 256, NEXP), 256, 0, stream>>>(w_gate, D, DE, (size_t)D * DE, wgu, D, 0, (size_t)1024 * D, 1);
    k_cvtT<<<dim3(D * DE / 256, NEXP), 256, 0, stream>>>(w_up, D, DE, (size_t)D * DE, wgu, D, 0, (size_t)1024 * D, 2);
    k_cvtT<<<dim3(DE * D / 256, NEXP), 256, 0, stream>>>(w_down, DE, D, (size_t)DE * D, wd, DE, 0, (size_t)1024 * DE, 0);
    k_fold1<<<4 * 2 * 128 * 128 / 256, 256, 0, stream>>>(wfour, cs);
    }
    if (OPT_MASK & 2) launch_phases(base, 1, 2, 0, grid_g, stream);
    else { k_fold2<<<dim3(D / 256, 1024), 256, 0, stream>>>(cs, w_out, wout_t); k_normmod<<<M + 512, 256, 0, stream>>>(x, ctx, gmix, modv, hl); }
    if (OPT_MASK & 4) launch_phases(base, 2, 3, 0, grid_g, stream);
    else { PInProj p{hl, win_t, rope, Q, Kb, Vb, F, D}; k_gemm<PInProj><<<dim3(2048 / 64, M / 64), 256, 0, stream>>>(p);
           PCtx p2{hc, win_t, Kb, Vb, D}; k_gemm<PCtx><<<dim3(1024 / 64, 512 / 64), 256, 0, stream>>>(p2); }
    if ((OPT_MASK & 8) || (OPT_MASK & 0x200)) launch_phases(base, 3, 4, 0, grid_g, stream, ((OPT_MASK & 8) ? 0 : 1) | ((OPT_MASK & 0x200) ? 0 : 2));
    if (!(OPT_MASK & 8)) k_attn<<<dim3(M, NH), 256, (2 * KV + 128 + 8 + 256) * 4, stream>>>(Q, Kb, Vb, amix, lq1, lk1, lq2, lk2, gsub);
    if (!(OPT_MASK & 0x200)) k_fft<<<dim3(128, 256), 256, 2 * 8192 * 4 + S * 4 * 2, stream>>>(F, amix);
    if (OPT_MASK & 16) launch_phases(base, 4, 5, 0, grid_g, stream);
    else { POut p{amix, wout_t, x, modv, xl, KO}; k_gemm<POut><<<dim3(D / 64, M / 64), 256, 0, stream>>>(p); }
    if (OPT_MASK & 32) launch_phases(base, 5, 6, 0, grid_g, stream);
    else k_router<<<M, 256, 0, stream>>>(xl, gffn, modv, wrg, brg, wre, bre, h2, ctl + CW_CNT, tokof, expid, posb, gate, (OPT_MASK & 16) ? (const float*)(ws + WS_SSQ) : nullptr);
    if (OPT_MASK & 64) launch_phases(base, 6, 7, 0, grid_g, stream);
    else { PGateUp p{h2, wgu, ctl + CW_CNT, tokof, hmid, D, 0, 0, 0}; k_gemm<PGateUp><<<dim3(1024 / 64, 256, NEXP), 256, 0, stream>>>(p); }
    if (OPT_MASK & 128) launch_phases(base, 7, 8, 0, grid_g, stream);
    else { PDown p{hmid, wd, ctl + CW_CNT, ybuf, DE, 0, 0, 0}; k_gemm<PDown><<<dim3(1024 / 64, 256, NEXP), 256, 0, stream>>>(p); }
    if (OPT_MASK & 256) launch_phases(base, 8, 9, 0, grid_g, stream);
    else k_final<<<M, 256, 0, stream>>>(xl, ybuf, ctl + CW_CNT, expid, posb, gate, modv, gfin, out);
#endif
}
```

```cpp
#include <hip/hip_runtime.h>
#include <cstdint>
#include <cstdio>

typedef unsigned short bf16;
constexpr int NB = 2, S = 8192, D = 1024, M = NB * S, CTX = 256, KV = CTX + S, NH = 4, NEXP = 32, DE = 512;
constexpr int KO = 1536;
constexpr float EPS = 1e-6f;
constexpr float C2 = 0.125f * 1.4426950408889634f;
constexpr int MAXSLOT = 40960;

constexpr size_t MiB = 1u << 20;
constexpr size_t WS_CTL = 0, CTL_ZERO_BYTES = 1 * MiB;
constexpr size_t WS_MOD = 1 * MiB;
constexpr size_t WS_ROPE = WS_MOD + 128 * 1024;
constexpr size_t WS_CS = WS_ROPE + 64 * 1024;
constexpr size_t WS_F1T = WS_CS + 512 * 1024;
constexpr size_t WS_TW = WS_F1T + 64 * 1024;
constexpr size_t WS_F2P = WS_TW + 64 * 1024;
constexpr size_t WS_RT = 2 * MiB;
constexpr size_t WS_TOKOF = 3 * MiB;
constexpr size_t WS_WRF = 5 * MiB;
constexpr size_t WS_SSQ = 7 * MiB;
constexpr size_t WS_WIN_T = 8 * MiB;
constexpr size_t WS_WOUT_T = 12 * MiB;
constexpr size_t WS_WGU = 16 * MiB;
constexpr size_t WS_WD = 80 * MiB;
constexpr size_t WS_C = 112 * MiB;
constexpr size_t WS_D = 192 * MiB;
constexpr size_t WS_END = 264 * MiB;
constexpr size_t WS_HL = WS_C, WS_HC = WS_C + (size_t)M * D * 2, WS_AMIX = WS_C, WS_YBUF = WS_C;
constexpr size_t WS_Q = WS_D, WS_K = WS_Q + (size_t)M * 512 * 2, WS_V = WS_K + (size_t)NB * KV * 512 * 2, WS_F = WS_V + (size_t)NB * KV * 512 * 2;
constexpr size_t WS_H2 = WS_D, WS_HMID = WS_D + (size_t)M * D * 2;
static_assert(WS_F + (size_t)M * 512 * 2 <= WS_END && WS_HMID + (size_t)MAXSLOT * DE * 2 <= WS_END, "region D");
constexpr int CW_CNT = 1024;

__device__ __forceinline__ float bf2f(bf16 v) { return __uint_as_float((unsigned)v << 16); }
__device__ __forceinline__ bf16 f2bf(float f) { unsigned u = __float_as_uint(f); return (bf16)((u + 0x7fffu + ((u >> 16) & 1u)) >> 16); }

__global__ void k_mod(const float* c, const float* cctx, const float* w_ada, const float* b_ada, float* modv) {
    const int v = blockIdx.y, j = blockIdx.x * 256 + threadIdx.x;
    const float* cv = v < 2 ? c + v * D : cctx;
    float acc = b_ada[j];
    for (int k = 0; k < D; ++k) { const float s = cv[k]; acc += (s / (1.f + expf(-s))) * w_ada[(size_t)k * 6144 + j]; }
    modv[v * 6144 + j] = acc;
}
__global__ void k_tables(float* rope) {
    const int t = blockIdx.x * 256 + threadIdx.x; if (t >= 128 * 16) return;
    const int pos = t >> 4, i = t & 15;
    const float inv = powf(10000.f, -(float)(2 * i) / 32.f), ang = (float)pos * inv;
    rope[t] = cosf(ang); rope[2048 + t] = sinf(ang);
}
__global__ void k_cvtT(const float* in, int K, int N, size_t istr, bf16* out, int ldo, int coloff, size_t ostr, int mode) {
    const size_t i = (size_t)blockIdx.x * 256 + threadIdx.x; if (i >= (size_t)K * N) return;
    const int e = blockIdx.y; const int k = (int)(i / N), n = (int)(i % N);
    int r = n;
    if (mode == 1) r = (n >> 4) * 32 + (n & 15); else if (mode == 2) r = (n >> 4) * 32 + 16 + (n & 15);
    out[e * ostr + (size_t)r * ldo + coloff + k] = f2bf(in[e * istr + i]);
}
__global__ void k_fft_tables(bf16* f1t, float2* tw, bf16* f2p) {
    const int t = blockIdx.x * 256 + threadIdx.x;
    if (t < 2 * 128 * 128) { const int part = t >> 14, k1 = (t >> 7) & 127, n1 = t & 127; const float x = (float)((k1 * n1) & 127) / 64.f; f1t[t] = f2bf(part ? -sinpif(x) : cospif(x)); }
    if (t < 64 * 128) { const int n2 = t >> 7, k1 = t & 127; const float x = (float)(n2 * k1) / 4096.f; tw[t] = make_float2(cospif(x), -sinpif(x)); }
    if (t < 3 * 64 * 64) { const int tab = t >> 12, k2 = (t >> 6) & 63, pos = t & 63, sp = pos >> 5, quad = (pos >> 3) & 3, jj = pos & 7;
        const int n2 = 32 * sp + (jj < 4 ? 4 * quad + jj : 16 + 4 * quad + (jj - 4)); const float x = (float)((n2 * k2) & 63) / 32.f;
        f2p[t] = f2bf(tab == 0 ? cospif(x) : (tab == 1 ? sinpif(x) : -sinpif(x))); }
}
__global__ void k_fold1(const float* wf, float* cs) {
    const int t = blockIdx.x * 256 + threadIdx.x;
    const int d = t & 127, c = (t >> 7) & 127, part = (t >> 14) & 1, g = t >> 15;
    float acc = 0.f;
    for (int kap = 0; kap < 128; ++kap) { const float x = (float)((c * kap) & 127) / 64.f; const float tr = part ? sinpif(x) : cospif(x); acc += tr * wf[((size_t)g * 128 + kap) * 128 + d]; }
    cs[t] = acc * (1.0f / 1024.0f);
}
__global__ void k_fold2(const float* cs, const float* w_out, bf16* wout_t) {
    const int n = blockIdx.x * 256 + threadIdx.x, kf = blockIdx.y;
    const int g = kf >> 8, c = (kf >> 1) & 127, part = kf & 1;
    const float* csr = cs + (((size_t)g * 2 + part) * 128 + c) * 128;
    float acc = 0.f;
    for (int d = 0; d < 128; ++d) acc += csr[d] * w_out[(size_t)(512 + g * 128 + d) * D + n];
    wout_t[(size_t)n * KO + 512 + kf] = f2bf(acc);
}
__device__ __forceinline__ float block_sum(float v, float* red) {
    for (int o = 1; o < 64; o <<= 1) v += __shfl_xor(v, o);
    __syncthreads(); if ((threadIdx.x & 63) == 0) red[threadIdx.x >> 6] = v; __syncthreads();
    float s = 0.f; for (int w = 0; w < (int)(blockDim.x >> 6); ++w) s += red[w]; return s;
}
__device__ __forceinline__ float block_max(float v, float* red) {
    for (int o = 1; o < 64; o <<= 1) v = fmaxf(v, __shfl_xor(v, o));
    __syncthreads(); if ((threadIdx.x & 63) == 0) red[threadIdx.x >> 6] = v; __syncthreads();
    float s = red[0]; for (int w = 1; w < (int)(blockDim.x >> 6); ++w) s = fmaxf(s, red[w]); return s;
}
__global__ void k_normmod(const float* x, const float* ctx, const float* g, const float* modv, bf16* hl) {
    __shared__ float red[8];
    const int row = blockIdx.x, t = threadIdx.x;
    const float* src = row < M ? x + (size_t)row * D : ctx + (size_t)(row - M) * D;
    const float* mv = modv + (row < M ? (row / S) : 2) * 6144;
    float v[4], ss = 0.f;
    for (int j = 0; j < 4; ++j) { v[j] = src[t + 256 * j]; ss += v[j] * v[j]; }
    const float rs = rsqrtf(block_sum(ss, red) / D + EPS);
    for (int j = 0; j < 4; ++j) { const int k = t + 256 * j; hl[(size_t)row * D + k] = f2bf((v[j] * rs * g[k]) * (1.f + mv[1024 + k]) + mv[k]); }
}

template <class P> __global__ __launch_bounds__(256) void k_gemm(P p) {
    __shared__ float As[32][65], Bs[32][65];
    __shared__ int sb_sh[2];
    if (!p.init(sb_sh)) return;
    const int tid = threadIdx.x, tx = tid & 15, ty = tid >> 4;
    const int lr = tid >> 2, lk = (tid & 3) * 8;
    const bf16* ar = p.arow(lr); const bf16* br = p.brow(lr);
    float acc[4][4] = {};
    for (int k0 = 0; k0 < p.K; k0 += 32) {
        const uint4 av = *(const uint4*)(ar + k0 + lk), bv = *(const uint4*)(br + k0 + lk);
        const unsigned aw[4] = {av.x, av.y, av.z, av.w}, bw[4] = {bv.x, bv.y, bv.z, bv.w};
        __syncthreads();
        for (int i = 0; i < 4; ++i) { As[lk + 2 * i][lr] = __uint_as_float(aw[i] << 16); As[lk + 2 * i + 1][lr] = __uint_as_float(aw[i] & 0xffff0000u);
                                      Bs[lk + 2 * i][lr] = __uint_as_float(bw[i] << 16); Bs[lk + 2 * i + 1][lr] = __uint_as_float(bw[i] & 0xffff0000u); }
        __syncthreads();
        for (int kk = 0; kk < 32; ++kk) { float a[4], b[4];
            for (int i = 0; i < 4; ++i) { a[i] = As[kk][ty + 16 * i]; b[i] = Bs[kk][tx + 16 * i]; }
            for (int i = 0; i < 4; ++i) for (int j = 0; j < 4; ++j) acc[i][j] += a[i] * b[j]; }
    }
    p.epi(ty, tx, acc);
}
struct PInProj {
    const bf16* hl; const bf16* wt; const float* rope; bf16 *Q, *Kb, *Vb, *F; int K;
    __device__ bool init(int*) { return true; }
    __device__ const bf16* arow(int r) const { return hl + (size_t)(blockIdx.y * 64 + r) * D; }
    __device__ const bf16* brow(int n) const { return wt + (size_t)(blockIdx.x * 64 + n) * D; }
    __device__ void epi(int ty, int tx, float (&acc)[4][4]) const {
        const int tn = blockIdx.x * 64, sec = tn >> 9;
        for (int i = 0; i < 4; ++i) { const int row = blockIdx.y * 64 + ty + 16 * i, b = row / S, s = row % S; float o[4];
            if (sec < 2) { const int p0 = s >> 6, p1 = s & 63; const float c0 = rope[p0 * 16 + tx], s0 = rope[2048 + p0 * 16 + tx], c1 = rope[p1 * 16 + tx], s1 = rope[2048 + p1 * 16 + tx];
                o[0] = acc[i][0] * c0 - acc[i][1] * s0; o[1] = acc[i][1] * c0 + acc[i][0] * s0; o[2] = acc[i][2] * c1 - acc[i][3] * s1; o[3] = acc[i][3] * c1 + acc[i][2] * s1;
            } else for (int j = 0; j < 4; ++j) o[j] = acc[i][j];
            for (int j = 0; j < 4; ++j) { const int col = (tn & 511) + tx + 16 * j;
                if (sec == 0) Q[(size_t)row * 512 + col] = f2bf(o[j] * C2);
                else if (sec == 1) Kb[((size_t)b * KV + CTX + s) * 512 + col] = f2bf(o[j]);
                else if (sec == 2) Vb[((size_t)b * KV + CTX + s) * 512 + col] = f2bf(o[j]);
                else { const int g = col >> 7, c = col & 127; F[((((size_t)b * 4 + g) * 32 + (c >> 2)) * S + s) * 4 + (c & 3)] = f2bf(o[j]); } } }
    }
};
struct PCtx {
    const bf16* hc; const bf16* wt; bf16 *Kb, *Vb; int K;
    __device__ bool init(int*) { return true; }
    __device__ const bf16* arow(int r) const { return hc + (size_t)(blockIdx.y * 64 + r) * D; }
    __device__ const bf16* brow(int n) const { return wt + (size_t)(512 + blockIdx.x * 64 + n) * D; }
    __device__ void epi(int ty, int tx, float (&acc)[4][4]) const {
        for (int i = 0; i < 4; ++i) { const int row = blockIdx.y * 64 + ty + 16 * i, b = row / CTX, j0 = row % CTX;
            for (int j = 0; j < 4; ++j) { const int col = blockIdx.x * 64 + tx + 16 * j; bf16* dst = col < 512 ? Kb : Vb;
                dst[((size_t)b * KV + j0) * 512 + (col & 511)] = f2bf(acc[i][j]); } }
    }
};
struct POut {
    const bf16* amix; const bf16* wt; const float* x; const float* modv; float* xl; int K;
    __device__ bool init(int*) { return true; }
    __device__ const bf16* arow(int r) const { return amix + (size_t)(blockIdx.y * 64 + r) * KO; }
    __device__ const bf16* brow(int n) const { return wt + (size_t)(blockIdx.x * 64 + n) * KO; }
    __device__ void epi(int ty, int tx, float (&acc)[4][4]) const {
        for (int i = 0; i < 4; ++i) { const int row = blockIdx.y * 64 + ty + 16 * i, b = row / S;
            for (int j = 0; j < 4; ++j) { const int col = blockIdx.x * 64 + tx + 16 * j; xl[(size_t)row * D + col] = x[(size_t)row * D + col] + modv[b * 6144 + 2048 + col] * acc[i][j]; } }
    }
};
__device__ __forceinline__ int slot_base(const unsigned* cnt, int e) { int sb = 0; for (int i = 0; i < e; ++i) sb += ((int)cnt[i * 64] + 255) >> 8; return sb * 256; }
struct PGateUp {
    const bf16* h2; const bf16* wgu; const unsigned* cnt; const int* tokof; bf16* hmid; int K; int e, n, sb;
    __device__ bool init(int* sh) { e = blockIdx.z; n = (int)cnt[e * 64]; if ((int)blockIdx.y * 64 >= n) return false;
        if (threadIdx.x == 0) sh[0] = slot_base(cnt, e); __syncthreads(); sb = sh[0]; return true; }
    __device__ const bf16* arow(int r) const { const int pos = blockIdx.y * 64 + r; const int tok = pos < n ? tokof[e * 16384 + pos] : 0; return h2 + (size_t)tok * D; }
    __device__ const bf16* brow(int nn) const { return wgu + ((size_t)e * 1024 + blockIdx.x * 64 + nn) * D; }
    __device__ void epi(int ty, int tx, float (&acc)[4][4]) const {
        for (int i = 0; i < 4; ++i) { const int pos = blockIdx.y * 64 + ty + 16 * i; if (pos >= n) continue;
            for (int jj = 0; jj < 2; ++jj) { const float gte = acc[i][2 * jj], up = acc[i][2 * jj + 1]; const int hc = (blockIdx.x * 2 + jj) * 16 + tx;
                hmid[(size_t)(sb + pos) * DE + hc] = f2bf((gte / (1.f + expf(-gte))) * up); } }
    }
};
struct PDown {
    const bf16* hmid; const bf16* wd; const unsigned* cnt; bf16* ybuf; int K; int e, n, sb;
    __device__ bool init(int* sh) { e = blockIdx.z; n = (int)cnt[e * 64]; if ((int)blockIdx.y * 64 >= n) return false;
        if (threadIdx.x == 0) sh[0] = slot_base(cnt, e); __syncthreads(); sb = sh[0]; return true; }
    __device__ const bf16* arow(int r) const { const int pos = blockIdx.y * 64 + r; return hmid + (size_t)(sb + (pos < n ? pos : 0)) * DE; }
    __device__ const bf16* brow(int nn) const { return wd + ((size_t)e * 1024 + blockIdx.x * 64 + nn) * DE; }
    __device__ void epi(int ty, int tx, float (&acc)[4][4]) const {
        for (int i = 0; i < 4; ++i) { const int pos = blockIdx.y * 64 + ty + 16 * i; if (pos >= n) continue;
            for (int j = 0; j < 4; ++j) ybuf[(size_t)(sb + pos) * D + blockIdx.x * 64 + tx + 16 * j] = f2bf(acc[i][j]); }
    }
};

__global__ __launch_bounds__(256) void k_attn(const bf16* Q, const bf16* Kb, const bf16* Vb, bf16* amix, const float* lq1, const float* lk1, const float* lq2, const float* lk2, const float* gsub) {
    extern __shared__ float sm[];
    float* s0 = sm; float* s1 = sm + KV; float* qs = sm + 2 * KV; float* red = qs + 128; float* osh = red + 8;
    const int row = blockIdx.x, h = blockIdx.y, b = row / S, t = threadIdx.x;
    if (t < 128) qs[t] = bf2f(Q[(size_t)row * 512 + h * 128 + t]);
    __syncthreads();
    float m0 = -1e30f, m1 = -1e30f;
    for (int key = t; key < KV; key += 256) { const bf16* kr = Kb + ((size_t)b * KV + key) * 512 + h * 128; float d0 = 0.f, d1 = 0.f;
        for (int d = 0; d < 64; ++d) { d0 += qs[d] * bf2f(kr[d]); d1 += qs[64 + d] * bf2f(kr[64 + d]); }
        s0[key] = d0; s1[key] = d1; m0 = fmaxf(m0, d0); m1 = fmaxf(m1, d1); }
    m0 = block_max(m0, red); m1 = block_max(m1, red);
    float l0 = 0.f, l1 = 0.f;
    for (int key = t; key < KV; key += 256) { const float p0 = exp2f(s0[key] - m0), p1 = exp2f(s1[key] - m1); s0[key] = p0; s1[key] = p1; l0 += p0; l1 += p1; }
    l0 = block_sum(l0, red); l1 = block_sum(l1, red);
    float a1 = 0.f, a2 = 0.f; for (int d = 0; d < 64; ++d) { a1 += lq1[d] * lk1[d]; a2 += lq2[d] * lk2[d]; }
    const float lam = expf(a1) - expf(a2) + 0.2f;
    const float i0 = 1.f / l0, i1 = lam / l1;
    for (int key = t; key < KV; key += 256) s0[key] = s0[key] * i0 - s1[key] * i1;
    __syncthreads();
    const int dv = t & 127, half = t >> 7; float o = 0.f;
    for (int key = half * (KV / 2); key < (half + 1) * (KV / 2); ++key) o += s0[key] * bf2f(Vb[((size_t)b * KV + key) * 512 + h * 128 + dv]);
    osh[t] = o; __syncthreads();
    o = osh[dv] + osh[128 + dv];
    const float ms = block_sum(t < 128 ? o * o : 0.f, red) / 128.f;
    if (t < 128) amix[(size_t)row * KO + h * 128 + dv] = f2bf(o * rsqrtf(ms + EPS) * gsub[dv] * 0.8f);
}
__global__ __launch_bounds__(256) void k_fft(const bf16* F, bf16* amix) {
    extern __shared__ float sm[];
    float2* tab = (float2*)sm; bf16* xs = (bf16*)(sm + 2 * 8192);
    const int u = blockIdx.y, t = threadIdx.x;
    for (int j = t; j < 8192; j += 256) { float sn, cs; sincospif((float)j / 4096.f, &sn, &cs); tab[j] = make_float2(cs, sn); }
    const bf16* xg = F + (size_t)u * S * 4;
    for (int j = t; j < S * 4 / 8; j += 256) ((uint4*)xs)[j] = ((const uint4*)xg)[j];
    __syncthreads();
    const int c = t & 3, k = blockIdx.x * 64 + (t >> 2);
    float re = 0.f, im = 0.f;
    for (int n = 0; n < S; ++n) { const float2 w = tab[(n * k) & 8191]; const float xv = bf2f(xs[n * 4 + c]); re += xv * w.x; im -= xv * w.y; }
    const int b = u >> 7, g = (u >> 5) & 3, cq = u & 31;
    bf16* dst = amix + ((size_t)b * S + k) * KO + 512 + g * 256 + 2 * (cq * 4 + c);
    dst[0] = f2bf(re); dst[1] = f2bf(im);
}
__global__ __launch_bounds__(256) void k_router(const float* xl, const float* gffn, const float* modv, const float* wrg, const float* brg, const float* wre, const float* bre,
                                                bf16* h2, unsigned* cnt, int* tokof, int* expid, int* posb, float* gate, const float* ssq16) {
    __shared__ float red[8]; __shared__ float hs[D]; __shared__ float lg[36];
    const int row = blockIdx.x, t = threadIdx.x, b = row / S;
    float v[4], ss = 0.f;
    for (int j = 0; j < 4; ++j) { v[j] = xl[(size_t)row * D + t + 256 * j]; ss += v[j] * v[j]; }
    float tot = block_sum(ss, red);
    if (ssq16) { tot = 0.f; for (int j = 0; j < 16; ++j) tot += ssq16[(size_t)row * 16 + j]; }
    const float rs = rsqrtf(tot / D + EPS);
    const float* mv = modv + b * 6144;
    for (int j = 0; j < 4; ++j) { const int k = t + 256 * j; const float hv = (v[j] * rs * gffn[k]) * (1.f + mv[4096 + k]) + mv[3072 + k]; hs[k] = hv; h2[(size_t)row * D + k] = f2bf(hv); }
    __syncthreads();
    const int w = t >> 6, lane = t & 63;
    for (int o = w; o < 36; o += 4) { float a = 0.f;
        for (int k = lane; k < D; k += 64) a += hs[k] * (o < 4 ? wrg[k * 4 + o] : wre[k * 32 + (o - 4)]);
        for (int s = 1; s < 64; s <<= 1) a += __shfl_xor(a, s);
        if (lane == 0) lg[o] = a + (o < 4 ? brg[o] : bre[o - 4]); }
    __syncthreads();
    if (t == 0) {
        int grp = 0; for (int i = 1; i < 4; ++i) if (lg[i] > lg[grp]) grp = i;
        float se = 0.f; for (int i = 0; i < 4; ++i) se += expf(lg[i] - lg[grp]);
        const float pg = 1.f / se;
        const float* el = lg + 4 + grp * 8;
        int i0 = 0; for (int i = 1; i < 8; ++i) if (el[i] > el[i0]) i0 = i;
        int i1 = (i0 == 0) ? 1 : 0; for (int i = 0; i < 8; ++i) if (i != i0 && el[i] > el[i1]) i1 = i;
        const float e1 = expf(el[i1] - el[i0]), g0 = pg / (1.f + e1), g1 = pg * e1 / (1.f + e1);
        const int ex[2] = {grp * 8 + i0, grp * 8 + i1}; const float gg[2] = {g0, g1};
        for (int k = 0; k < 2; ++k) { const int pos = (int)atomicAdd(&cnt[ex[k] * 64], 1u); tokof[ex[k] * 16384 + pos] = row;
            expid[row * 2 + k] = ex[k]; posb[row * 2 + k] = pos; gate[row * 2 + k] = gg[k]; }
    }
}
__global__ __launch_bounds__(256) void k_final(const float* xl, const bf16* ybuf, const unsigned* cnt, const int* expid, const int* posb, const float* gate, const float* modv, const float* gfin, float* out) {
    __shared__ float red[8]; __shared__ int sl[2];
    const int row = blockIdx.x, t = threadIdx.x, b = row / S;
    if (t < 2) sl[t] = slot_base(cnt, expid[row * 2 + t]) + posb[row * 2 + t];
    __syncthreads();
    const bf16* y0 = ybuf + (size_t)sl[0] * D; const bf16* y1 = ybuf + (size_t)sl[1] * D;
    float v[4], ss = 0.f;
    for (int j = 0; j < 4; ++j) { const int k = t + 256 * j; v[j] = xl[(size_t)row * D + k] + modv[b * 6144 + 5120 + k] * (gate[row * 2] * bf2f(y0[k]) + gate[row * 2 + 1] * bf2f(y1[k])); ss += v[j] * v[j]; }
    const float rs = rsqrtf(block_sum(ss, red) / D + EPS);
    for (int j = 0; j < 4; ++j) { const int k = t + 256 * j; out[(size_t)row * D + k] = v[j] * rs * gfin[k]; }
}

namespace pg8 {
#define PG8_LAS __attribute__((address_space(3)))
typedef unsigned short bf16_t;
typedef short bf16x8 __attribute__((ext_vector_type(8)));
typedef float f32x4 __attribute__((ext_vector_type(4)));
typedef unsigned u32x4 __attribute__((ext_vector_type(4)));
constexpr int BM = 256, BK = 64, HALF = 128, HTB = HALF * BK * 2  , STAGE_BYTES = 8 * HTB, NXCD = 8, WGM = 8;

__host__ __device__ __forceinline__ int lds_byte(int r, int c) { const int st = (r >> 4) * 2 + (c >> 5), rr = r & 15, cc = c & 31, ob = rr * 64 + cc * 2; return st * 1024 + (ob ^ (((ob >> 9) & 1) << 5)); }
__host__ __device__ __forceinline__ void stage_rc(int b, int& R, int& C) { const int st = b / 1024, sb = b % 1024, swz = sb ^ (((sb >> 9) & 1) << 5); R = (st >> 1) * 16 + swz / 64; C = (st & 1) * 32 + (swz % 64) / 2; }
__host__ __device__ __forceinline__ int perm32(int rho) { const int n = rho >> 4, i = rho & 15; return 8 * (i >> 2) + 4 * n + (i & 3); }

struct Unit { int pm, pn; };
struct Gemm { const bf16_t* A; const bf16_t* Bt; int M, N, K; };

struct StaticOrder {
    int nM, nN, nwg, G, c;
    __host__ __device__ void init(int M, int N, int G_, int c_) { nM = M / BM; nN = N / BM; nwg = nM * nN; G = G_; c = c_; }
    __host__ __device__ bool next(int i, Unit& u) const {
        const long L = (long)i * G + c; if (L >= nwg) return false;
        int wgid = (int)L; { const int q = nwg / NXCD, r = nwg % NXCD, xcd = wgid % NXCD, off = wgid / NXCD; wgid = (xcd < r ? xcd * (q + 1) : r * (q + 1) + (xcd - r) * q) + off; }
        const int nig = WGM * nN, gid = wgid / nig, fm = gid * WGM, gsz = (nM - fm) < WGM ? (nM - fm) : WGM;
        u.pm = fm + ((wgid % nig) % gsz); u.pn = (wgid % nig) / gsz; return true;
    }
    __device__ __forceinline__ void a_ready(const Unit&) const {}
    __device__ __forceinline__ void done(const Unit&) const {}
};

__device__ __forceinline__ unsigned cvt_pk_bf16(float lo, float hi) { typedef float f32x2_t __attribute__((ext_vector_type(2))); typedef __bf16 bf16x2_t __attribute__((ext_vector_type(2))); const f32x2_t v = {lo, hi}; return __builtin_bit_cast(unsigned, __builtin_convertvector(v, bf16x2_t)); }
typedef unsigned u32x2 __attribute__((ext_vector_type(2)));
__device__ __forceinline__ u32x2 pack4(f32x4 v) { u32x2 w; w.x = cvt_pk_bf16(v[0], v[1]); w.y = cvt_pk_bf16(v[2], v[3]); return w; }
struct EpiInProj {
    static constexpr bool PERM = false, AFTER_DRAIN = false;
    bf16_t *Q, *Kb, *Vb, *F; const float* rope;
    __device__ __forceinline__ void operator()(const f32x4 (&acc)[2][2][4][2], const Unit& u, int wr, int wc, int fr, int fq) const {
        const int sec = u.pn >> 1, colh = (u.pn & 1) * 256 + wc * 32 + 4 * fq;
#pragma unroll
        for (int ai = 0; ai < 2; ++ai)
#pragma unroll
            for (int m = 0; m < 4; ++m) {
                const int row = u.pm * BM + ai * HALF + wr * 64 + m * 16 + fr, b = row >> 13, s = row & 8191;
                if (sec < 2) {
                    const int pos = (wc & 1) ? (s & 63) : (s >> 6);
                    const f32x4 cs = *(const f32x4*)(rope + pos * 16 + 4 * fq), sn = *(const f32x4*)(rope + 2048 + pos * 16 + 4 * fq);
                    bf16_t* dst = sec == 0 ? Q + (size_t)row * 512 + colh : Kb + ((size_t)b * 8448 + 256 + s) * 512 + colh;
                    const float sc = sec == 0 ? 0.125f * 1.4426950408889634f : 1.f;
#pragma unroll
                    for (int bj = 0; bj < 2; ++bj) { const f32x4 x1 = acc[ai][bj][m][0], x2 = acc[ai][bj][m][1];
                        *(u32x2*)(dst + bj * HALF) = pack4((x1 * cs - x2 * sn) * sc); *(u32x2*)(dst + bj * HALF + 16) = pack4((x2 * cs + x1 * sn) * sc); }
                } else if (sec == 2) {
                    bf16_t* dst = Vb + ((size_t)b * 8448 + 256 + s) * 512 + colh;
#pragma unroll
                    for (int bj = 0; bj < 2; ++bj) { *(u32x2*)(dst + bj * HALF) = pack4(acc[ai][bj][m][0]); *(u32x2*)(dst + bj * HALF + 16) = pack4(acc[ai][bj][m][1]); }
                } else {
#pragma unroll
                    for (int bj = 0; bj < 2; ++bj)
#pragma unroll
                        for (int n = 0; n < 2; ++n) { const int g = (u.pn & 1) * 2 + bj, cq = 8 * wc + 4 * n + fq;
                            *(u32x2*)(F + ((((size_t)b * 4 + g) * 32 + cq) * 8192 + s) * 4) = pack4(acc[ai][bj][m][n]); }
                }
            }
    }
};
struct EpiOut {
    static constexpr bool PERM = false, AFTER_DRAIN = false;
    const float* x; const float* modv; float* xl; float* ssq;
    __device__ __forceinline__ void operator()(const f32x4 (&acc)[2][2][4][2], const Unit& u, int wr, int wc, int fr, int fq) const {
        const int col0 = u.pn * BM + wc * 32 + 4 * fq;
#pragma unroll
        for (int ai = 0; ai < 2; ++ai)
#pragma unroll
            for (int m = 0; m < 4; ++m) {
                const int row = u.pm * BM + ai * HALF + wr * 64 + m * 16 + fr, b = row >> 13; const size_t off = (size_t)row * 1024 + col0; const float* gt = modv + b * 6144 + 2048 + col0;
                float ss = 0.f;
#pragma unroll
                for (int bj = 0; bj < 2; ++bj)
#pragma unroll
                    for (int n = 0; n < 2; ++n) { const f32x4 xv = *(const f32x4*)(x + off + bj * HALF + n * 16), gv = *(const f32x4*)(gt + bj * HALF + n * 16);
                        const f32x4 o = xv + gv * acc[ai][bj][m][n]; *(f32x4*)(xl + off + bj * HALF + n * 16) = o; ss += (o[0] * o[0] + o[1] * o[1]) + (o[2] * o[2] + o[3] * o[3]); }
                ss += __shfl_xor(ss, 16); ss += __shfl_xor(ss, 32);
                if (fq == 0) ssq[(size_t)row * 16 + u.pn * 4 + wc] = ss;
                if (m & 1) asm volatile("" ::: "memory");
            }
    }
};
struct EpiGateUp {
    static constexpr bool PERM = false, AFTER_DRAIN = false;
    bf16_t* hmid;
    __device__ __forceinline__ void operator()(const f32x4 (&acc)[2][2][4][2], const Unit& u, int wr, int wc, int fr, int fq) const {
#pragma unroll
        for (int ai = 0; ai < 2; ++ai)
#pragma unroll
            for (int m = 0; m < 4; ++m) { const int slot = u.pm * BM + ai * HALF + wr * 64 + m * 16 + fr;
#pragma unroll
                for (int bj = 0; bj < 2; ++bj) { const f32x4 gv = acc[ai][bj][m][0], uv = acc[ai][bj][m][1]; f32x4 o;
#pragma unroll
                    for (int j = 0; j < 4; ++j) o[j] = gv[j] * __builtin_amdgcn_rcpf(1.f + __builtin_amdgcn_exp2f(-1.4426950408889634f * gv[j])) * uv[j];
                    *(u32x2*)(hmid + (size_t)slot * 512 + (8 * (u.pn & 3) + 4 * bj + wc) * 16 + 4 * fq) = pack4(o); } }
    }
};
struct EpiDown {
    static constexpr bool PERM = true, AFTER_DRAIN = false;
    bf16_t* ybuf;
    __device__ __forceinline__ void operator()(const f32x4 (&acc)[2][2][4][2], const Unit& u, int wr, int wc, int fr, int fq) const {
        const int col0 = (u.pn & 3) * BM + wc * 32 + 8 * fq;
#pragma unroll
        for (int ai = 0; ai < 2; ++ai)
#pragma unroll
            for (int m = 0; m < 4; ++m) { bf16_t* rowp = ybuf + (size_t)(u.pm * BM + ai * HALF + wr * 64 + m * 16 + fr) * 1024 + col0;
#pragma unroll
                for (int bj = 0; bj < 2; ++bj) { const f32x4 v0 = acc[ai][bj][m][0], v1 = acc[ai][bj][m][1]; u32x4 w; w.x = cvt_pk_bf16(v0[0], v0[1]); w.y = cvt_pk_bf16(v0[2], v0[3]); w.z = cvt_pk_bf16(v1[0], v1[1]); w.w = cvt_pk_bf16(v1[2], v1[3]);
                    *(u32x4*)(rowp + bj * HALF) = w; } }
    }
};
struct MoeOrder {
    int nunits, G, c; const PG8_LAS int* tb; const PG8_LAS int* toks;
    __device__ __forceinline__ bool next(int i, Unit& u) const {
        const int L = i * G + c; if (L >= nunits) return false;
        const int tile = L >> 2; int e = 0;
        for (int j = 1; j < 32; ++j) e += (tb[j] <= tile) ? 1 : 0;
        u.pm = tile; u.pn = e * 4 + (L & 3); return true;
    }
    __device__ __forceinline__ int arow(int i, int r) const { return toks[i * 256 + r]; }
    __device__ __forceinline__ void a_ready(const Unit&) const {}
    __device__ __forceinline__ void done(const Unit&) const {}
};
template <class Epi, class Sched, bool ALIGN_EPI = false, bool SP2 = false, bool GATHER = false>
__device__ __forceinline__ void gemm_phase(PG8_LAS unsigned char* lds, const Gemm g, const Sched& S, const Epi& E) {
    const int tid = threadIdx.x, wid = __builtin_amdgcn_readfirstlane(tid >> 6), lane = tid & 63, wr = wid >> 2, wc = wid & 3, fr = lane & 15, fq = lane >> 4;
    const int K = g.K, nt = K / BK;
    unsigned voffA[2], voffB[2]; int gR0 = 0; unsigned gC0 = 0u;
    unsigned vA[2][2];
#pragma unroll
    for (int i = 0; i < 2; ++i) { int R, C; stage_rc(tid * 16 + i * 8192, R, C); const int Rb = Epi::PERM ? ((R & ~31) + perm32(R & 31)) : R;
        voffA[i] = (unsigned)(R * K + C) * 2u; voffB[i] = (unsigned)(Rb * K + C) * 2u; if (i == 0) { gR0 = R; gC0 = (unsigned)C * 2u; } }
    const size_t kstep = (size_t)(BK * 2);
    const size_t hstep = (size_t)HALF * K * 2;
    const size_t tstep = 2 * hstep;
    const unsigned ldsw = (unsigned)wid * 1024u;
    const int aoff = lds_byte(wr * 64 + fr, fq * 8), boff = lds_byte(wc * 32 + fr, fq * 8);
#define PG8_SA(b, h) (((b) * 2 + (h)) * HTB)
#define PG8_SB(b, h) ((4 + (b) * 2 + (h)) * HTB)
#define PG8_STAGE(bufoff, gbase, voff) do { _Pragma("unroll") for (int _i = 0; _i < 2; ++_i) \
        __builtin_amdgcn_global_load_lds((const unsigned*)((const char*)(gbase) + (voff)[_i]), (PG8_LAS unsigned*)(lds + (bufoff) + ldsw + _i * 8192), 16, 0, 0); } while (0)
#define PG8_STAGE_A(bufoff, gbase, h, nx) do { if constexpr (GATHER) { PG8_STAGE(bufoff, gbase, vA[h]); } else { PG8_STAGE(bufoff, (gbase) + (h) * hstep, voffA); } } while (0)
#define PG8_GATHER_OFFS(dst, uidx) do { _Pragma("unroll") for (int _h = 0; _h < 2; ++_h) _Pragma("unroll") for (int _i = 0; _i < 2; ++_i) dst[_h][_i] = (unsigned)S.arow(uidx, _h * HALF + gR0 + 64 * _i) * (unsigned)(K * 2) + gC0; } while (0)
#define PG8_LDA(dst, b, h) do { _Pragma("unroll") for (int m = 0; m < 4; ++m) _Pragma("unroll") for (int k = 0; k < 2; ++k) dst[m][k] = *(const PG8_LAS bf16x8*)(lds + PG8_SA(b, h) + aoff + m * 2048 + k * 1024); } while (0)
#define PG8_LDB(dst, b, h) do { _Pragma("unroll") for (int n = 0; n < 2; ++n) _Pragma("unroll") for (int k = 0; k < 2; ++k) dst[n][k] = *(const PG8_LAS bf16x8*)(lds + PG8_SB(b, h) + boff + n * 2048 + k * 1024); } while (0)
#define PG8_MMA(ai, bj, At, Bt) do { __builtin_amdgcn_s_setprio(1); _Pragma("unroll") for (int m = 0; m < 4; ++m) _Pragma("unroll") for (int n = 0; n < 2; ++n) _Pragma("unroll") for (int k = 0; k < 2; ++k) \
        acc[ai][bj][m][n] = __builtin_amdgcn_mfma_f32_16x16x32_bf16(Bt[n][k], At[m][k], acc[ai][bj][m][n], 0, 0, 0); __builtin_amdgcn_s_setprio(0); } while (0)
#define PG8_WAIT_V(n) asm volatile("s_waitcnt vmcnt(" #n ")" ::: "memory")
#define PG8_WAIT_L(n) asm volatile("s_waitcnt lgkmcnt(" #n ")" ::: "memory")
#define PG8_BAR __builtin_amdgcn_s_barrier()
#define PG8_SCHED __builtin_amdgcn_sched_barrier(0)
    Unit cur, nxt; int ui = 0;
    if (!S.next(0, cur)) return;
    f32x4 acc[2][2][4][2];
#pragma unroll
    for (int a = 0; a < 2; ++a)
#pragma unroll
        for (int b = 0; b < 2; ++b)
#pragma unroll
            for (int m = 0; m < 4; ++m)
#pragma unroll
                for (int n = 0; n < 2; ++n) acc[a][b][m][n] = (f32x4){0.f, 0.f, 0.f, 0.f};
    bf16x8 At[4][2], B0[2][2], B1[2][2];
    const char* cA = GATHER ? (const char*)g.A : (const char*)g.A + (size_t)cur.pm * tstep; const char* cB = (const char*)g.Bt + (size_t)cur.pn * tstep;
    if constexpr (GATHER) { PG8_GATHER_OFFS(vA, 0); }
    S.a_ready(cur);
    if constexpr (SP2) {
        PG8_STAGE(PG8_SB(0, 0), cB, voffB); PG8_STAGE(PG8_SB(0, 1), cB + hstep, voffB); PG8_STAGE_A(PG8_SA(0, 0), cA, 0, false); PG8_STAGE_A(PG8_SA(0, 1), cA, 1, false);
        if (wr == 1) PG8_BAR;
        PG8_WAIT_V(2); PG8_BAR;
        PG8_STAGE(PG8_SB(1, 0), cB + kstep, voffB); PG8_STAGE_A(PG8_SA(1, 0), cA + kstep, 0, false); PG8_STAGE(PG8_SB(1, 1), cB + hstep + kstep, voffB);
        PG8_WAIT_V(6); PG8_BAR;
    } else {
        PG8_STAGE(PG8_SB(0, 0), cB, voffB); PG8_STAGE_A(PG8_SA(0, 0), cA, 0, false); PG8_STAGE(PG8_SB(0, 1), cB + hstep, voffB); PG8_STAGE_A(PG8_SA(0, 1), cA, 1, false);
        if (wr == 1) PG8_BAR;
        PG8_WAIT_V(4); PG8_BAR;
        PG8_STAGE(PG8_SB(1, 0), cB + kstep, voffB); PG8_STAGE_A(PG8_SA(1, 0), cA + kstep, 0, false); PG8_STAGE(PG8_SB(1, 1), cB + hstep + kstep, voffB);
        PG8_WAIT_V(6); PG8_BAR;
    }
    for (;;) {
        const bool has_next = S.next(ui + 1, nxt);
        const char* nA = GATHER ? cA : (has_next ? (const char*)g.A + (size_t)nxt.pm * tstep : cA); const char* nB = has_next ? (const char*)g.Bt + (size_t)nxt.pn * tstep : cB;

        for (int t = 0; t < nt; t += 2) {
            const bool last = (t == nt - 2);
            const char* a1 = cA + (size_t)(t + 1) * kstep;
            const char* a2 = last ? nA : cA + (size_t)(t + 2) * kstep; const char* b2 = last ? nB : cB + (size_t)(t + 2) * kstep;
            const char* a3 = a2 + kstep; const char* b3 = b2 + kstep;
            if (last && has_next) S.a_ready(nxt);
            if constexpr (SP2) {
            PG8_LDB(B0, 0, 0); PG8_LDB(B1, 0, 1); PG8_SCHED; PG8_LDA(At, 0, 0); PG8_STAGE_A(PG8_SA(1, 1), a1, 1, false);
            if constexpr (GATHER) { if (last && has_next) { PG8_GATHER_OFFS(vA, ui + 1); } }
            PG8_WAIT_V(8); PG8_WAIT_L(0); PG8_BAR; PG8_MMA(0, 0, At, B0); PG8_MMA(0, 1, At, B1); PG8_BAR; PG8_SCHED;
            PG8_LDA(At, 0, 1); PG8_STAGE(PG8_SB(0, 0), b2, voffB); PG8_STAGE(PG8_SB(0, 1), b2 + hstep, voffB); PG8_STAGE_A(PG8_SA(0, 0), a2, 0, last);
            PG8_WAIT_V(8); PG8_WAIT_L(0); PG8_BAR; PG8_MMA(1, 0, At, B0); PG8_MMA(1, 1, At, B1); PG8_BAR; PG8_SCHED;
            PG8_LDB(B0, 1, 0); PG8_LDB(B1, 1, 1); PG8_SCHED; PG8_LDA(At, 1, 0); PG8_STAGE_A(PG8_SA(0, 1), a2, 1, last);
            PG8_WAIT_V(8); PG8_WAIT_L(0); PG8_BAR; PG8_MMA(0, 0, At, B0); PG8_MMA(0, 1, At, B1); PG8_BAR; PG8_SCHED;
            PG8_LDA(At, 1, 1); PG8_STAGE(PG8_SB(1, 0), b3, voffB); PG8_STAGE(PG8_SB(1, 1), b3 + hstep, voffB); PG8_STAGE_A(PG8_SA(1, 0), a3, 0, last);
            PG8_WAIT_V(8); PG8_WAIT_L(0); PG8_BAR; PG8_MMA(1, 0, At, B0); PG8_MMA(1, 1, At, B1); PG8_BAR; PG8_SCHED;
            } else {
            PG8_LDB(B0, 0, 0); PG8_SCHED; PG8_LDA(At, 0, 0); PG8_STAGE_A(PG8_SA(1, 1), a1, 1, false);
            if constexpr (GATHER) { if (last && has_next) { PG8_GATHER_OFFS(vA, ui + 1); } }
            PG8_WAIT_L(8); PG8_BAR; PG8_WAIT_L(0); PG8_MMA(0, 0, At, B0); PG8_BAR; PG8_SCHED;
            PG8_LDB(B1, 0, 1); PG8_STAGE(PG8_SB(0, 0), b2, voffB);
            PG8_BAR; PG8_WAIT_L(0); PG8_MMA(0, 1, At, B1); PG8_BAR;
            PG8_LDA(At, 0, 1); PG8_STAGE_A(PG8_SA(0, 0), a2, 0, last);
            PG8_BAR; PG8_WAIT_L(0); PG8_MMA(1, 0, At, B0); PG8_BAR; PG8_SCHED;
            PG8_STAGE(PG8_SB(0, 1), b2 + hstep, voffB);
            PG8_WAIT_V(6); PG8_BAR; PG8_MMA(1, 1, At, B1); PG8_BAR;
            PG8_LDB(B0, 1, 0); PG8_SCHED; PG8_LDA(At, 1, 0); PG8_STAGE_A(PG8_SA(0, 1), a2, 1, last);
            PG8_WAIT_L(8); PG8_BAR; PG8_WAIT_L(0); PG8_MMA(0, 0, At, B0); PG8_BAR; PG8_SCHED;
            PG8_LDB(B1, 1, 1); PG8_STAGE(PG8_SB(1, 0), b3, voffB);
            PG8_BAR; PG8_WAIT_L(0); PG8_MMA(0, 1, At, B1); PG8_BAR;
            PG8_LDA(At, 1, 1); PG8_STAGE_A(PG8_SA(1, 0), a3, 0, last);
            PG8_BAR; PG8_WAIT_L(0); PG8_MMA(1, 0, At, B0); PG8_BAR; PG8_SCHED;
            PG8_STAGE(PG8_SB(1, 1), b3 + hstep, voffB);
            PG8_WAIT_V(6); PG8_BAR; PG8_MMA(1, 1, At, B1); PG8_BAR;
            }
        }
        if constexpr (ALIGN_EPI) { if (wr == 0) PG8_BAR; }
        if constexpr (!Epi::AFTER_DRAIN) { E(acc, cur, wr, wc, fr, fq); S.done(cur); }
        if (!has_next) break;
#pragma unroll
        for (int a = 0; a < 2; ++a)
#pragma unroll
            for (int b = 0; b < 2; ++b)
#pragma unroll
                for (int m = 0; m < 4; ++m)
#pragma unroll
                    for (int n = 0; n < 2; ++n) acc[a][b][m][n] = (f32x4){0.f, 0.f, 0.f, 0.f};
        cur = nxt; cA = nA; cB = nB; ++ui;
        if constexpr (ALIGN_EPI) { if (wr == 1) PG8_BAR; }
    }
    PG8_WAIT_V(0);
    if constexpr (!ALIGN_EPI) { if (wr == 0) PG8_BAR; }
    PG8_BAR;
    if constexpr (Epi::AFTER_DRAIN) { E.fused(acc, cur, wr, wc, fr, fq, lds, wid, lane); S.done(cur); }
#undef PG8_SA
#undef PG8_SB
#undef PG8_STAGE
#undef PG8_STAGE_A
#undef PG8_GATHER_OFFS
#undef PG8_LDA
#undef PG8_LDB
#undef PG8_MMA
#undef PG8_WAIT_V
#undef PG8_WAIT_L
#undef PG8_BAR
#undef PG8_SCHED
}
}

#define GAS __attribute__((address_space(1)))
#define LAS __attribute__((address_space(3)))
typedef GAS unsigned gu32;
#define RLX_AGENT __ATOMIC_RELAXED, __HIP_MEMORY_SCOPE_AGENT
#define LDS_WAIT() asm volatile("s_waitcnt lgkmcnt(0)" ::: "memory")
#define VM_WAIT() asm volatile("s_waitcnt vmcnt(0)" ::: "memory")

#define XB_TMO      128
#define XB_XCNT(j)  (256  + 64 * (j))
#define XB_XSUB(j)  (1280 + 64 * (j))
#define XB_XGEN(j)  (2304 + 64 * (j))
#define XB_TOP      3328
#define XB_TOPGEN   3392
#define XCD_BAR_WORDS 3456
#define XB_SPIN_CAP (1u << 18)

__device__ __forceinline__ unsigned xb_ld(unsigned* p)              { return __hip_atomic_load(p, __ATOMIC_RELAXED, __HIP_MEMORY_SCOPE_AGENT); }
__device__ __forceinline__ unsigned xb_add(unsigned* p, unsigned v) { return __hip_atomic_fetch_add(p, v, __ATOMIC_RELAXED, __HIP_MEMORY_SCOPE_AGENT); }
__device__ __forceinline__ unsigned xb_xcc_id() { return (unsigned)__builtin_amdgcn_s_getreg((3 << 11) | 20) & 0xFu; }
#define XB_SPIN(cond, bar) do { unsigned _sp = 0; while (cond) { __builtin_amdgcn_s_sleep(1); \
    if ((++_sp & 255u) == 0u) { if (xb_ld(&(bar)[XB_TMO])) break; if (_sp > XB_SPIN_CAP) { atomicAdd(&(bar)[XB_TMO], 1u); break; } } } } while (0)

struct XcdBarrier {
    unsigned* bar; unsigned x;
    volatile LAS unsigned* st;
};

__device__ __forceinline__ XcdBarrier xcd_barrier_post(unsigned* bar, volatile LAS unsigned* st) {
    XcdBarrier b; b.bar = bar; b.x = xb_xcc_id(); b.st = st;
    if (threadIdx.x == 0) (void)xb_add(&bar[XB_XCNT(b.x)], 1u);
    return b;
}
__device__ __forceinline__ void xcd_barrier_complete(unsigned* bar, unsigned x, unsigned& nloc, unsigned& nx) {
    const unsigned G = gridDim.x * gridDim.y * gridDim.z;
    unsigned sum, cnt, mine, sp = 0u;
    for (;;) {
        sum = 0u; cnt = 0u; mine = 0u;
#pragma unroll
        for (unsigned j = 0; j < 16; ++j) { const unsigned c = xb_ld(&bar[XB_XCNT(j)]); sum += c; cnt += (c > 0u) ? 1u : 0u; mine = (j == x) ? c : mine; }
        if (sum == G) break;
        __builtin_amdgcn_s_sleep(1);
        if ((++sp & 255u) == 0u) { if (xb_ld(&bar[XB_TMO])) break; if (sp > XB_SPIN_CAP) { atomicAdd(&bar[XB_TMO], 1u); break; } }
    }
    nloc = mine > 0u ? mine : 1u; nx = cnt > 0u ? cnt : 1u;
}

__device__ __forceinline__ void xcd_barrier(const XcdBarrier& b) {
    asm volatile("s_waitcnt vmcnt(0)" ::: "memory");
    __syncthreads();
    if (threadIdx.x == 0) {
        unsigned* bar = b.bar;
        __builtin_amdgcn_s_waitcnt(0);
        unsigned nloc = b.st[0], nx = b.st[1];
        if (nloc == 0u) { xcd_barrier_complete(bar, b.x, nloc, nx); b.st[0] = nloc; b.st[1] = nx; }
        const unsigned old = xb_add(&bar[XB_XSUB(b.x)], 1u);
        const unsigned gen = old / nloc;
        if (old + 1u == (gen + 1u) * nloc) {
            __builtin_amdgcn_fence(__ATOMIC_RELEASE, "agent");
            asm volatile("s_waitcnt vmcnt(0)" ::: "memory");
            const unsigned og = xb_add(&bar[XB_TOP], 1u);
            const unsigned tg = og / nx;
            if (og + 1u == (tg + 1u) * nx) xb_add(&bar[XB_TOPGEN], 1u);
            else XB_SPIN(xb_ld(&bar[XB_TOPGEN]) == tg, bar);
            __builtin_amdgcn_fence(__ATOMIC_ACQUIRE, "agent");
            xb_add(&bar[XB_XGEN(b.x)], 1u);
            asm volatile("s_waitcnt vmcnt(0)" ::: "memory");
        } else {
            XB_SPIN(xb_ld(&bar[XB_XGEN(b.x)]) == gen, bar);
            __builtin_amdgcn_fence(__ATOMIC_ACQUIRE, "agent");
            asm volatile("s_waitcnt vmcnt(0)" ::: "memory");
        }
    }
    __syncthreads();
}

namespace da {
using bf16x8 = __attribute__((ext_vector_type(8))) short;
using s16x4  = __attribute__((ext_vector_type(4))) short;
using f32x16 = __attribute__((ext_vector_type(16))) float;
using u32x4  = __attribute__((ext_vector_type(4))) unsigned;
constexpr int NW = 8, QBLK = 32, KVBLK = 64, LDK = 512;
constexpr int NSLOT = 3, SHM_V = KVBLK * 128 * 2, SHM_K = KVBLK * 128 * 2, SHM_ATTN = NSLOT * (SHM_V + SHM_K) + NW * 64 * 4;
constexpr float THRL = 8.f;
#define DA_KSWZ(row, colB) ((row) * 256 + ((colB) ^ (((row) & 7) << 4)))
#define DA_SBAR() __builtin_amdgcn_sched_barrier(0)
__device__ __forceinline__ int crow(int r, int hi) { return (r & 3) + 8 * (r >> 2) + 4 * hi; }
__device__ __forceinline__ unsigned cvtpk(float lo, float hi) { typedef float f32x2_t __attribute__((ext_vector_type(2))); typedef __bf16 bf16x2_t __attribute__((ext_vector_type(2))); const f32x2_t v = {lo, hi}; return __builtin_bit_cast(unsigned, __builtin_convertvector(v, bf16x2_t)); }
__device__ __forceinline__ void partialSM(f32x16& p0, f32x16& p1, float& m_reg, float& mn, float& alpha) {
  float pmax = p0[0];
#pragma unroll
  for (int r = 1; r < 16; ++r) pmax = fmaxf(pmax, p0[r]);
#pragma unroll
  for (int r = 0; r < 16; ++r) pmax = fmaxf(pmax, p1[r]);
  { auto rr = __builtin_amdgcn_permlane32_swap(__float_as_uint(pmax), __float_as_uint(pmax), false, false);
    pmax = fmaxf(__uint_as_float(rr[0]), __uint_as_float(rr[1])); }
  if (__builtin_expect(__all(pmax - m_reg <= THRL), 1)) { mn = m_reg; alpha = 1.f; }
  else { mn = fmaxf(m_reg, pmax); alpha = __builtin_amdgcn_exp2f(m_reg - mn); m_reg = mn; }
#pragma unroll
  for (int r = 0; r < 16; ++r) p0[r] = p0[r] - mn;
#pragma unroll
  for (int r = 0; r < 16; ++r) p1[r] = p1[r] - mn;
#pragma unroll
  for (int r = 0; r < 16; ++r) p0[r] = __builtin_amdgcn_exp2f(p0[r]);
}
__device__ __forceinline__ void finishSM(f32x16& p0, f32x16& p1, float alpha, float& l_reg, bf16x8& pa0, bf16x8& pa1, bf16x8& pa2, bf16x8& pa3) {
#pragma unroll
  for (int r = 0; r < 16; ++r) p1[r] = __builtin_amdgcn_exp2f(p1[r]);
  float ps = 0;
#pragma unroll
  for (int r = 0; r < 16; ++r) ps += p0[r];
#pragma unroll
  for (int r = 0; r < 16; ++r) ps += p1[r];
  { auto rr = __builtin_amdgcn_permlane32_swap(__float_as_uint(ps), __float_as_uint(ps), false, false);
    ps = __uint_as_float(rr[0]) + __uint_as_float(rr[1]); }
  l_reg = l_reg * alpha + ps;
#define DA_PK4(P, BASE, OUT) do { unsigned a0 = cvtpk(P[BASE + 0], P[BASE + 1]), a1 = cvtpk(P[BASE + 2], P[BASE + 3]);   \
    unsigned b0 = cvtpk(P[BASE + 4], P[BASE + 5]), b1 = cvtpk(P[BASE + 6], P[BASE + 7]);                              \
    auto r0 = __builtin_amdgcn_permlane32_swap(a0, b0, false, false); auto r1 = __builtin_amdgcn_permlane32_swap(a1, b1, false, false); \
    u32x4 w = {r0[0], r1[0], r0[1], r1[1]}; OUT = __builtin_bit_cast(bf16x8, w); } while (0)
  DA_PK4(p0, 0, pa0); DA_PK4(p0, 8, pa1); DA_PK4(p1, 0, pa2); DA_PK4(p1, 8, pa3);
#undef DA_PK4
}
__device__ __forceinline__ void fakeSM(f32x16& p0, f32x16& p1, bf16x8& pa0, bf16x8& pa1, bf16x8& pa2, bf16x8& pa3) {
#define DA_PK4(P, BASE, OUT) do { unsigned a0 = cvtpk(P[BASE + 0], P[BASE + 1]), a1 = cvtpk(P[BASE + 2], P[BASE + 3]), b0 = cvtpk(P[BASE + 4], P[BASE + 5]), b1 = cvtpk(P[BASE + 6], P[BASE + 7]); \
    u32x4 w = {a0, a1, b0, b1}; OUT = __builtin_bit_cast(bf16x8, w); } while (0)
  DA_PK4(p0, 0, pa0); DA_PK4(p0, 8, pa1); DA_PK4(p1, 0, pa2); DA_PK4(p1, 8, pa3);
#undef DA_PK4
}
__device__ __forceinline__ void qkt(f32x16& p0, f32x16& p1, const LAS char* Ks, const bf16x8* qr, int r32, int hi, int mb) {
  p0 = f32x16{}; p1 = f32x16{};
#pragma unroll
  for (int d0 = 0; d0 < 4; ++d0) { const int cb = mb + (d0 * 16 + hi * 8) * 2;
    const bf16x8 b0 = *(const LAS bf16x8*)(Ks + DA_KSWZ(r32, cb));
    const bf16x8 b1 = *(const LAS bf16x8*)(Ks + DA_KSWZ(32 + r32, cb));
    p0 = __builtin_amdgcn_mfma_f32_32x32x16_bf16(b0, qr[d0], p0, 0, 0, 0);
    p1 = __builtin_amdgcn_mfma_f32_32x32x16_bf16(b1, qr[d0], p1, 0, 0, 0); }
}
__device__ __forceinline__ void glds16(const void* gsrc, unsigned lds_dst) { unsigned keep;
  asm volatile("s_mov_b32 %0, m0\n\ts_mov_b32 m0, %2\n\ts_nop 0\n\tglobal_load_lds_dwordx4 %1, off\n\ts_mov_b32 m0, %0" : "=&s"(keep) : "v"(gsrc), "s"(lds_dst) : "memory"); }
__device__ __forceinline__ int v_st(int k, int c) { const int kk = (k & ~0xC) | ((k & 4) << 1) | ((k & 8) >> 1); return ((kk >> 3) * 4 + (c >> 5)) * 512 + ((kk & 7) * 32 + (c & 31)) * 2; }
__device__ __forceinline__ int v_rd_base(int lane) { return ((lane & 3) << 3) | (((lane >> 2) & 3) << 6) | (((lane >> 4) & 1) << 5) | (((lane >> 5) & 1) << 8); }
constexpr int v_rd_off(int d0, int ks, int half) { return d0 * 512 + ks * 4096 + half * 2048; }
template <int OFF> __device__ __forceinline__ s16x4 tr_read(int vb) { s16x4 r; asm volatile("ds_read_b64_tr_b16 %0, %1 offset:%2" : "=&v"(r) : "v"(vb), "i"(OFF) : "memory"); return r; }
template <int D0> __device__ __forceinline__ void pv_one(f32x16& od, int vb, bf16x8 pa0, bf16x8 pa1, bf16x8 pa2, bf16x8 pa3) {
  const s16x4 l0 = tr_read<v_rd_off(D0, 0, 0)>(vb), h0 = tr_read<v_rd_off(D0, 0, 1)>(vb), l1 = tr_read<v_rd_off(D0, 1, 0)>(vb), h1 = tr_read<v_rd_off(D0, 1, 1)>(vb);
  const s16x4 l2 = tr_read<v_rd_off(D0, 2, 0)>(vb), h2 = tr_read<v_rd_off(D0, 2, 1)>(vb), l3 = tr_read<v_rd_off(D0, 3, 0)>(vb), h3 = tr_read<v_rd_off(D0, 3, 1)>(vb);
  asm volatile("s_waitcnt lgkmcnt(0)" ::: "memory"); DA_SBAR();
#define DA_PK(L, H) (bf16x8){L[0], L[1], L[2], L[3], H[0], H[1], H[2], H[3]}
  od = __builtin_amdgcn_mfma_f32_32x32x16_bf16(pa0, DA_PK(l0, h0), od, 0, 0, 0);
  od = __builtin_amdgcn_mfma_f32_32x32x16_bf16(pa1, DA_PK(l1, h1), od, 0, 0, 0);
  od = __builtin_amdgcn_mfma_f32_32x32x16_bf16(pa2, DA_PK(l2, h2), od, 0, 0, 0);
  od = __builtin_amdgcn_mfma_f32_32x32x16_bf16(pa3, DA_PK(l3, h3), od, 0, 0, 0);
#undef DA_PK
}
__device__ __forceinline__ void pv_d0(f32x16* o, int vb, bf16x8 pa0, bf16x8 pa1, bf16x8 pa2, bf16x8 pa3) {
  pv_one<0>(o[0], vb, pa0, pa1, pa2, pa3); pv_one<1>(o[1], vb, pa0, pa1, pa2, pa3); pv_one<2>(o[2], vb, pa0, pa1, pa2, pa3); pv_one<3>(o[3], vb, pa0, pa1, pa2, pa3);
}
__device__ __forceinline__ void pv_psm(f32x16* o, int vb, bf16x8 pa0, bf16x8 pa1, bf16x8 pa2, bf16x8 pa3, f32x16& p0, f32x16& p1, float& m_reg, float& mn, float& alpha) {
#define DA_PK(L, H) (bf16x8){L[0], L[1], L[2], L[3], H[0], H[1], H[2], H[3]}
#define DA_RD8(D0) const s16x4 l0 = tr_read<v_rd_off(D0, 0, 0)>(vb), h0 = tr_read<v_rd_off(D0, 0, 1)>(vb), l1 = tr_read<v_rd_off(D0, 1, 0)>(vb), h1 = tr_read<v_rd_off(D0, 1, 1)>(vb), \
    l2 = tr_read<v_rd_off(D0, 2, 0)>(vb), h2 = tr_read<v_rd_off(D0, 2, 1)>(vb), l3 = tr_read<v_rd_off(D0, 3, 0)>(vb), h3 = tr_read<v_rd_off(D0, 3, 1)>(vb)
#define DA_MM4(D0) do { asm volatile("s_waitcnt lgkmcnt(0)" ::: "memory"); DA_SBAR(); \
    o[D0] = __builtin_amdgcn_mfma_f32_32x32x16_bf16(pa0, DA_PK(l0, h0), o[D0], 0, 0, 0); o[D0] = __builtin_amdgcn_mfma_f32_32x32x16_bf16(pa1, DA_PK(l1, h1), o[D0], 0, 0, 0); \
    o[D0] = __builtin_amdgcn_mfma_f32_32x32x16_bf16(pa2, DA_PK(l2, h2), o[D0], 0, 0, 0); o[D0] = __builtin_amdgcn_mfma_f32_32x32x16_bf16(pa3, DA_PK(l3, h3), o[D0], 0, 0, 0); } while (0)
  float pmax;
  { DA_RD8(0);
    pmax = p0[0];
#pragma unroll
    for (int r = 1; r < 16; ++r) pmax = fmaxf(pmax, p0[r]);
    DA_MM4(0); }
  { DA_RD8(1);
#pragma unroll
    for (int r = 0; r < 16; ++r) pmax = fmaxf(pmax, p1[r]);
    { auto rr = __builtin_amdgcn_permlane32_swap(__float_as_uint(pmax), __float_as_uint(pmax), false, false);
      pmax = fmaxf(__uint_as_float(rr[0]), __uint_as_float(rr[1])); }
    if (__builtin_expect(__all(pmax - m_reg <= THRL), 1)) { mn = m_reg; alpha = 1.f; }
    else { mn = fmaxf(m_reg, pmax); alpha = __builtin_amdgcn_exp2f(m_reg - mn); m_reg = mn; }
    DA_MM4(1); }
  { DA_RD8(2);
#pragma unroll
    for (int r = 0; r < 16; ++r) p0[r] = p0[r] - mn;
#pragma unroll
    for (int r = 0; r < 16; ++r) p1[r] = p1[r] - mn;
    DA_MM4(2); }
  { DA_RD8(3);
#pragma unroll
    for (int r = 0; r < 16; ++r) p0[r] = __builtin_amdgcn_exp2f(p0[r]);
    DA_MM4(3); }
#undef DA_PK
#undef DA_RD8
#undef DA_MM4
}
template <int VAR> __device__ __forceinline__ void attn_unit(const bf16* __restrict__ Qb, const bf16* __restrict__ Kh, const bf16* __restrict__ Vh, bf16* __restrict__ Ob, int ldo, int seq,
                                          LAS unsigned char* lds, unsigned lds0, float lam, const float (&gs)[4]) {
  const int tid = threadIdx.x, wid = __builtin_amdgcn_readfirstlane(tid >> 6), lane = tid & 63, r32 = lane & 31, hi = lane >> 5, map = wid >> 2, rg = wid & 3, mb = map * 128;
  LAS char* V_lds = (LAS char*)lds; LAS char* K_lds = (LAS char*)lds + NSLOT * SHM_V;
  LAS float* ws = (LAS float*)(lds + NSLOT * (SHM_V + SHM_K)) + wid * 64; LAS float* li_l = ws; LAS float* al_l = ws + 32;
  float m_reg = -1e30f, l_reg = 0; f32x16 o[4] = {}; bf16x8 qr[4];
  const bf16* Qw = Qb + (long)(rg * QBLK + r32) * 512 + map * 64 + hi * 8;
#pragma unroll
  for (int d0 = 0; d0 < 4; ++d0) qr[d0] = *(const bf16x8*)(Qw + d0 * 16);
  const int vb0 = (int)lds0 + v_rd_base(lane);
  const bf16* ksrc0; const bf16* ksrc1; const bf16* vsrc0; const bf16* vsrc1;
  { const int r0 = 8 * wid + (lane >> 4), r1 = r0 + 4, cp = lane & 15;
    ksrc0 = Kh + (long)r0 * LDK + ((cp ^ (r0 & 7)) << 3); ksrc1 = Kh + (long)r1 * LDK + ((cp ^ (r1 & 7)) << 3);
    const int kk = 8 * wid + ((lane & 31) >> 2), key = (kk & ~0xC) | ((kk & 4) << 1) | ((kk & 8) >> 1), c0 = 32 * (lane >> 5) + 8 * (lane & 3);
    vsrc0 = Vh + (long)key * LDK + c0; vsrc1 = vsrc0 + 64; }
  const unsigned kdst = lds0 + NSLOT * SHM_V + (unsigned)wid * 2048u, vdst = lds0 + (unsigned)wid * 2048u;
#define DA_DMA(t, so) do { const long go_ = (long)(t) * (KVBLK * LDK); const unsigned kd_ = (unsigned)__builtin_amdgcn_readfirstlane((int)(kdst + (unsigned)(so))), vd_ = (unsigned)__builtin_amdgcn_readfirstlane((int)(vdst + (unsigned)(so))); \
    glds16(ksrc0 + go_, kd_); glds16(ksrc1 + go_, kd_ + 1024u); glds16(vsrc0 + go_, vd_); glds16(vsrc1 + go_, vd_ + 1024u); } while (0)
#define DA_VM0() asm volatile("s_waitcnt vmcnt(0)" ::: "memory")
#define DA_RESC(a) do { if (__any((a) < 1.f)) { if (hi == 0) al_l[r32] = (a); asm volatile("s_waitcnt lgkmcnt(0)" ::: "memory"); \
    _Pragma("unroll") for (int d = 0; d < 4; ++d) _Pragma("unroll") for (int r = 0; r < 16; ++r) o[d][r] *= al_l[crow(r, hi)]; } } while (0)
#define DA_BAR() do { asm volatile("s_waitcnt lgkmcnt(0)" ::: "memory"); __builtin_amdgcn_s_barrier(); asm volatile("" ::: "memory"); } while (0)
#define DA_STEP(PC0, PC1, ALC, PN0, PN1, MNN, ALN, j) do { \
    if constexpr (!(VAR & 1)) { if ((j) + 2 < NT) DA_DMA((j) + 2, s2); } \
    DA_SBAR(); qkt(PN0, PN1, K_lds + s1, qr, r32, hi, mb); \
    if constexpr (VAR & 2) { fakeSM(PC0, PC1, pa0, pa1, pa2, pa3); } else { finishSM(PC0, PC1, ALC, l_reg, pa0, pa1, pa2, pa3); } DA_SBAR(); \
    if constexpr (VAR & 2) { pv_d0(o, vb0 + s0, pa0, pa1, pa2, pa3); } else { pv_psm(o, vb0 + s0, pa0, pa1, pa2, pa3, PN0, PN1, m_reg, MNN, ALN); } \
    if constexpr (!(VAR & 2)) { DA_RESC(ALN); } DA_VM0(); DA_BAR(); \
    { const int t_ = s0; s0 = s1; s1 = s2; s2 = t_; } } while (0)
  f32x16 pA0, pA1, pB0, pB1; float mnA, mnB, alA, alB; bf16x8 pa0, pa1, pa2, pa3; const int NT = seq / KVBLK;
  int s0 = 0, s1 = SHM_V, s2 = 2 * SHM_V;
  DA_DMA(0, 0); DA_DMA(1, SHM_V); DA_VM0(); DA_BAR();
  qkt(pA0, pA1, K_lds, qr, r32, hi, mb); partialSM(pA0, pA1, m_reg, mnA, alA); DA_RESC(alA);
  int j = 0;
  for (; j + 2 < NT; j += 2) {
    DA_STEP(pA0, pA1, alA, pB0, pB1, mnB, alB, j);
    DA_STEP(pB0, pB1, alB, pA0, pA1, mnA, alA, j + 1);
  }
  DA_STEP(pA0, pA1, alA, pB0, pB1, mnB, alB, j);
  finishSM(pB0, pB1, alB, l_reg, pa0, pa1, pa2, pa3); DA_SBAR();
  pv_d0(o, vb0 + s0, pa0, pa1, pa2, pa3);
  if (hi == 0) li_l[r32] = l_reg; asm volatile("s_waitcnt lgkmcnt(0)" ::: "memory");
  float rli[16];
#pragma unroll
  for (int r = 0; r < 16; ++r) rli[r] = __builtin_amdgcn_rcpf(li_l[crow(r, hi)]);
  asm volatile("s_waitcnt vmcnt(0)" ::: "memory");
  __syncthreads();
  LAS float* xch = (LAS float*)lds + rg * 4096 + lane;
  if (map == 1) {
#pragma unroll
    for (int d0 = 0; d0 < 4; ++d0)
#pragma unroll
      for (int r = 0; r < 16; ++r) xch[(d0 * 16 + r) * 64] = o[d0][r] * (rli[r] * lam);
  }
  asm volatile("s_waitcnt lgkmcnt(0)" ::: "memory");
  __syncthreads();
  if (map == 0) {
    float ss[16];
#pragma unroll
    for (int r = 0; r < 16; ++r) ss[r] = 0.f;
#pragma unroll
    for (int d0 = 0; d0 < 4; ++d0)
#pragma unroll
      for (int r = 0; r < 16; ++r) { const float v = o[d0][r] * rli[r] - xch[(d0 * 16 + r) * 64]; o[d0][r] = v; ss[r] += v * v; }
#pragma unroll
    for (int r = 0; r < 16; ++r) { float s = ss[r]; s += __shfl_xor(s, 1); s += __shfl_xor(s, 2); s += __shfl_xor(s, 4); s += __shfl_xor(s, 8); s += __shfl_xor(s, 16);
      ss[r] = __builtin_amdgcn_rsqf(s * (1.f / 128.f) + 1e-6f); }
    bf16* Ow = Ob + (long)(rg * QBLK) * ldo + r32;
#pragma unroll
    for (int r = 0; r < 16; ++r) { const int orow = crow(r, hi);
#pragma unroll
      for (int d0 = 0; d0 < 4; ++d0) { const unsigned w = cvtpk(o[d0][r] * ss[r] * gs[d0], 0.f); Ow[(long)orow * ldo + d0 * 32] = (bf16)(w & 0xffffu); } }
  }
  asm volatile("s_waitcnt lgkmcnt(0)" ::: "memory");
  __syncthreads();
#undef DA_DMA
#undef DA_VM0
#undef DA_RESC
#undef DA_BAR
#undef DA_STEP
}
#undef DA_KSWZ
#undef DA_SBAR
}
namespace fft {
using bf16x8 = __attribute__((ext_vector_type(8))) short;
using f32x4v = __attribute__((ext_vector_type(4))) float;
using u32x4 = __attribute__((ext_vector_type(4))) unsigned;
constexpr int XROW = 272;
constexpr int LDS_FFT = 4 * 64 * XROW;
__device__ __forceinline__ unsigned cvtpk(float lo, float hi) { typedef float f32x2_t __attribute__((ext_vector_type(2))); typedef __bf16 bf16x2_t __attribute__((ext_vector_type(2))); const f32x2_t v = {lo, hi}; return __builtin_bit_cast(unsigned, __builtin_convertvector(v, bf16x2_t)); }
__device__ __forceinline__ void fft_unit(const bf16* __restrict__ xg, bf16* __restrict__ out, int ldo, const bf16* __restrict__ F1T, const float2* __restrict__ TW, const bf16* __restrict__ F2P, LAS unsigned char* lds) {
  const int tid = threadIdx.x, lane = tid & 63, wave = __builtin_amdgcn_readfirstlane(tid >> 6), l16 = lane & 15, quad = lane >> 4;
#pragma unroll
  for (int it = 0; it < 8; ++it) { const int p = it * 512 + tid, n = 2 * p, n1 = n >> 6, n2 = n & 63;
    const uint4 v = ((const uint4*)xg)[p];
    LAS unsigned short* b0 = (LAS unsigned short*)(lds + n2 * XROW + n1 * 2);
    b0[(0 * 64) * (XROW / 2)] = (unsigned short)(v.x & 0xffffu); b0[(1 * 64) * (XROW / 2)] = (unsigned short)(v.x >> 16);
    b0[(2 * 64) * (XROW / 2)] = (unsigned short)(v.y & 0xffffu); b0[(3 * 64) * (XROW / 2)] = (unsigned short)(v.y >> 16);
    b0[(0 * 64 + 1) * (XROW / 2)] = (unsigned short)(v.z & 0xffffu); b0[(1 * 64 + 1) * (XROW / 2)] = (unsigned short)(v.z >> 16);
    b0[(2 * 64 + 1) * (XROW / 2)] = (unsigned short)(v.w & 0xffffu); b0[(3 * 64 + 1) * (XROW / 2)] = (unsigned short)(v.w >> 16); }
  bf16x8 f1[2][4]; float2 tw[4][4];
#pragma unroll
  for (int part = 0; part < 2; ++part)
#pragma unroll
    for (int s = 0; s < 4; ++s) f1[part][s] = *(const bf16x8*)(F1T + ((size_t)(part * 128 + 16 * wave + l16) * 128 + 32 * s + 8 * quad));
#pragma unroll
  for (int t = 0; t < 4; ++t)
#pragma unroll
    for (int j = 0; j < 4; ++j) tw[t][j] = TW[(16 * t + 4 * quad + j) * 128 + 16 * wave + l16];
  asm volatile("s_waitcnt lgkmcnt(0)" ::: "memory");
  __syncthreads();
  bf16x8 A2[4][2][2];
#pragma unroll
  for (int c = 0; c < 4; ++c) {
    f32x4v acc[4][2];
#pragma unroll
    for (int t = 0; t < 4; ++t) { acc[t][0] = (f32x4v){0.f, 0.f, 0.f, 0.f}; acc[t][1] = (f32x4v){0.f, 0.f, 0.f, 0.f}; }
#pragma unroll
    for (int t = 0; t < 4; ++t)
#pragma unroll
      for (int s = 0; s < 4; ++s) { const bf16x8 a = *(const LAS bf16x8*)(lds + (c * 64 + 16 * t + l16) * XROW + (32 * s + 8 * quad) * 2);
        acc[t][0] = __builtin_amdgcn_mfma_f32_16x16x32_bf16(a, f1[0][s], acc[t][0], 0, 0, 0);
        acc[t][1] = __builtin_amdgcn_mfma_f32_16x16x32_bf16(a, f1[1][s], acc[t][1], 0, 0, 0); }
    f32x4v pr[4], pi[4];
#pragma unroll
    for (int t = 0; t < 4; ++t)
#pragma unroll
      for (int j = 0; j < 4; ++j) { const float tr = acc[t][0][j], ti = acc[t][1][j]; const float2 w = tw[t][j]; pr[t][j] = tr * w.x - ti * w.y; pi[t][j] = tr * w.y + ti * w.x; }
#pragma unroll
    for (int sp = 0; sp < 2; ++sp) {
      u32x4 wr_ = {cvtpk(pr[2 * sp][0], pr[2 * sp][1]), cvtpk(pr[2 * sp][2], pr[2 * sp][3]), cvtpk(pr[2 * sp + 1][0], pr[2 * sp + 1][1]), cvtpk(pr[2 * sp + 1][2], pr[2 * sp + 1][3])};
      u32x4 wi_ = {cvtpk(pi[2 * sp][0], pi[2 * sp][1]), cvtpk(pi[2 * sp][2], pi[2 * sp][3]), cvtpk(pi[2 * sp + 1][0], pi[2 * sp + 1][1]), cvtpk(pi[2 * sp + 1][2], pi[2 * sp + 1][3])};
      A2[c][0][sp] = __builtin_bit_cast(bf16x8, wr_); A2[c][1][sp] = __builtin_bit_cast(bf16x8, wi_); }
  }
#pragma unroll
  for (int v = 0; v < 4; ++v) {
    bf16x8 bc[2], bs[2], bn[2];
#pragma unroll
    for (int sp = 0; sp < 2; ++sp) { const size_t o = (size_t)(16 * v + l16) * 64 + sp * 32 + quad * 8;
      bc[sp] = *(const bf16x8*)(F2P + o); bs[sp] = *(const bf16x8*)(F2P + 4096 + o); bn[sp] = *(const bf16x8*)(F2P + 8192 + o); }
    f32x4v dr[4], di[4];
#pragma unroll
    for (int c = 0; c < 4; ++c) { dr[c] = (f32x4v){0.f, 0.f, 0.f, 0.f}; di[c] = (f32x4v){0.f, 0.f, 0.f, 0.f};
#pragma unroll
      for (int sp = 0; sp < 2; ++sp) {
        dr[c] = __builtin_amdgcn_mfma_f32_16x16x32_bf16(A2[c][0][sp], bc[sp], dr[c], 0, 0, 0);
        dr[c] = __builtin_amdgcn_mfma_f32_16x16x32_bf16(A2[c][1][sp], bs[sp], dr[c], 0, 0, 0);
        di[c] = __builtin_amdgcn_mfma_f32_16x16x32_bf16(A2[c][0][sp], bn[sp], di[c], 0, 0, 0);
        di[c] = __builtin_amdgcn_mfma_f32_16x16x32_bf16(A2[c][1][sp], bc[sp], di[c], 0, 0, 0); } }
#pragma unroll
    for (int j = 0; j < 4; ++j) { const int tok = 16 * wave + 4 * quad + j + 128 * (16 * v + l16);
      u32x4 w = {cvtpk(dr[0][j], di[0][j]), cvtpk(dr[1][j], di[1][j]), cvtpk(dr[2][j], di[2][j]), cvtpk(dr[3][j], di[3][j])};
      *(u32x4*)(out + (size_t)tok * ldo) = w; }
  }
  __syncthreads();
}
}
constexpr int NWAVES = 8;
constexpr int RING_OFF = 0, RING_BYTES = 131072;
constexpr int LDSX_OFF = 163840 - 8192;
constexpr int MISC_OFF = LDSX_OFF, TB_OFF = LDSX_OFF + 512, TOKS_OFF = LDSX_OFF + 1024;
constexpr int LDS_BYTES = 163840;
static_assert(TOKS_OFF + 4 * 256 * 4 <= LDS_BYTES, "LDS map");
constexpr int CW_BAR = 4096;
namespace thin {
typedef float f32x4 __attribute__((ext_vector_type(4)));
typedef float f32x2 __attribute__((ext_vector_type(2)));
typedef unsigned u32x4 __attribute__((ext_vector_type(4)));
typedef unsigned u32x2 __attribute__((ext_vector_type(2)));
typedef short bf16x8 __attribute__((ext_vector_type(8)));
__device__ __forceinline__ unsigned pk2(float lo, float hi) { typedef float f32x2_t __attribute__((ext_vector_type(2))); typedef __bf16 bf16x2_t __attribute__((ext_vector_type(2))); const f32x2_t v = {lo, hi}; return __builtin_bit_cast(unsigned, __builtin_convertvector(v, bf16x2_t)); }
__device__ __forceinline__ float wave_sum(float v) {
#pragma unroll
    for (int o = 1; o < 64; o <<= 1) v += __shfl_xor(v, o);
    return v;
}
__device__ __forceinline__ void transpose_item(const float* W, int N, bf16* WT, int ldo, int mode, LAS float* scr, int item, int lane) {
    const int nblk = N / 32, kb = item / nblk, nb = item % nblk, k0 = 64 * kb, n0 = 32 * nb;
#pragma unroll 8
    for (int i = 0; i < 32; ++i) { const int kk = 2 * i + (lane >> 5); scr[kk * 33 + (lane & 31)] = W[(size_t)(k0 + kk) * N + n0 + (lane & 31)]; }
    LDS_WAIT(); asm volatile("" ::: "memory");
    const int c = lane & 7;
#pragma unroll
    for (int j = 0; j < 4; ++j) { const int nl = (lane >> 3) + 8 * j, n = n0 + nl; const LAS float* s = scr + (8 * c) * 33 + nl;
        const int row = mode == 0 ? n : ((n >> 4) * 32 + (n & 15) + (mode == 2 ? 16 : 0));
        u32x4 o; o.x = pk2(s[0 * 33], s[1 * 33]); o.y = pk2(s[2 * 33], s[3 * 33]); o.z = pk2(s[4 * 33], s[5 * 33]); o.w = pk2(s[6 * 33], s[7 * 33]);
        *(u32x4*)(WT + (size_t)row * ldo + k0 + 8 * c) = o; }
    LDS_WAIT(); asm volatile("" ::: "memory");
}
struct P0Args { const float *c, *cctx, *w_ada, *b_ada, *w_in, *w_out, *w_gate, *w_up, *w_down, *wfour, *wrg, *wre; float *modv, *rope, *cs; bf16 *f1t; float2* tw; bf16 *f2p, *wrf, *win_t, *wout_t, *wgu, *wd; };
__device__ __forceinline__ void p0_prologue(const P0Args& a, LAS unsigned char* lds, int bx, int G, int tid, int lane, int wave) {
    for (int u = bx; u < 192; u += G) {
        const int col0 = u * 32, c4 = tid & 7, kk = tid >> 3;
        f32x4 acc[3] = {};
#pragma unroll 4
        for (int i = 0; i < 16; ++i) { const int k = kk + 64 * i; const f32x4 w = *(const f32x4*)(a.w_ada + (size_t)k * 6144 + col0 + 4 * c4);
#pragma unroll
            for (int v = 0; v < 3; ++v) { const float s = v < 2 ? a.c[v * D + k] : a.cctx[k]; acc[v] += (s / (1.f + expf(-s))) * w; } }
        LAS f32x4* red = (LAS f32x4*)lds;
#pragma unroll
        for (int v = 0; v < 3; ++v) red[(kk * 3 + v) * 8 + c4] = acc[v];
        __syncthreads();
        if (tid < 96) { const int v = tid >> 5, col = tid & 31; float s = a.b_ada[col0 + col];
            for (int q = 0; q < 64; ++q) s += ((LAS float*)lds)[((q * 3 + v) * 8) * 4 + col];
            a.modv[v * 6144 + col0 + col] = s; }
        __syncthreads();
    }
    const int gt = bx * 512 + tid, NT = G * 512;
    for (int t = gt; t < 2048; t += NT) { const int pos = t >> 4, i = t & 15; const float inv = powf(10000.f, -(float)(2 * i) / 32.f), ang = (float)pos * inv; a.rope[t] = cosf(ang); a.rope[2048 + t] = sinf(ang); }
    for (int t = gt; t < 32768; t += NT) {
        { const int part = t >> 14, k1 = (t >> 7) & 127, n1 = t & 127; const float x = (float)((k1 * n1) & 127) / 64.f; a.f1t[t] = (bf16)(pk2(part ? -sinpif(x) : cospif(x), 0.f) & 0xffffu); }
        if (t < 8192) { const int n2 = t >> 7, k1 = t & 127; const float x = (float)(n2 * k1) / 4096.f; a.tw[t] = make_float2(cospif(x), -sinpif(x)); }
        if (t < 12288) { const int tab = t >> 12, k2 = (t >> 6) & 63, pos = t & 63, sp = pos >> 5, quad = (pos >> 3) & 3, jj = pos & 7;
            const int n2 = 32 * sp + (jj < 4 ? 4 * quad + jj : 16 + 4 * quad + (jj - 4)); const float x = (float)((n2 * k2) & 63) / 32.f;
            a.f2p[t] = (bf16)(pk2(tab == 0 ? cospif(x) : (tab == 1 ? sinpif(x) : -sinpif(x)), 0.f) & 0xffffu); } }
    for (int t = gt; t < 32 * 3 * 2 * 64 * 8; t += NT) { const int j = t & 7, ln = (t >> 3) & 63, hl = (t >> 9) & 1, nt = (t >> 10) % 3, s = t / 3072;
        const int k = 32 * s + 8 * (ln >> 4) + j, e = 16 * nt + (ln & 15);
        const float w = e < 4 ? a.wrg[k * 4 + e] : (e < 36 ? a.wre[k * 32 + (e - 4)] : 0.f);
        const unsigned hi = pk2(w, 0.f) & 0xffffu; const float lo = w - __uint_as_float(hi << 16);
        a.wrf[t] = (bf16)(hl ? (pk2(lo, 0.f) & 0xffffu) : hi); }
    { LAS float* tr = (LAS float*)lds;
      if (tid < 128) { tr[tid] = cospif((float)tid / 64.f); tr[128 + tid] = sinpif((float)tid / 64.f); }
      __syncthreads();
      for (int t = gt; t < 131072; t += NT) { const int d = t & 127, c = (t >> 7) & 127, part = (t >> 14) & 1, g = t >> 15; float acc = 0.f;
#pragma unroll 8
          for (int kap = 0; kap < 128; ++kap) acc += tr[part * 128 + ((c * kap) & 127)] * a.wfour[((size_t)g * 128 + kap) * 128 + d];
          a.cs[t] = acc * (1.0f / 1024.0f); }
      __syncthreads(); }
    { LAS float* scr = (LAS float*)(lds + wave * 16384);
      const int gw = bx * 8 + wave, NGW = G * 8;
      constexpr int I_IN = 16 * 64, I_OUT = 8 * 32, I_G = 16 * 16, I_D = 8 * 32, NITEMS = I_IN + I_OUT + NEXP * (2 * I_G + I_D);
      for (int it = gw; it < NITEMS; it += NGW) { int r = it;
          if (r < I_IN) { transpose_item(a.w_in, 2048, a.win_t, D, 0, scr, r, lane); continue; } r -= I_IN;
          if (r < I_OUT) { transpose_item(a.w_out, D, a.wout_t, KO, 0, scr, r, lane); continue; } r -= I_OUT;
          const int e = r / (2 * I_G + I_D); r -= e * (2 * I_G + I_D);
          if (r < I_G) { transpose_item(a.w_gate + (size_t)e * D * DE, DE, a.wgu + (size_t)e * 1024 * D, D, 1, scr, r, lane); continue; } r -= I_G;
          if (r < I_G) { transpose_item(a.w_up + (size_t)e * D * DE, DE, a.wgu + (size_t)e * 1024 * D, D, 2, scr, r, lane); continue; } r -= I_G;
          transpose_item(a.w_down + (size_t)e * DE * D, D, a.wd + (size_t)e * 1024 * DE, DE, 0, scr, r, lane); } }
}
__device__ __forceinline__ void p1_norms(const float* x, const float* ctx, const float* gmix, const float* modv, bf16* hl, const float* cs, const float* w_out, bf16* wout_t,
                                         LAS unsigned char* lds, int bx, int G, int tid, int lane, int wave) {
    for (int u = bx; u < 128; u += G) {
        const int g = u >> 5, kb = u & 31; LAS float* csl = (LAS float*)lds;
        for (int t = tid; t < 1024; t += 512) { const int i = t >> 7, d = t & 127; csl[t] = cs[(((size_t)g * 2 + (i & 1)) * 128 + 4 * kb + (i >> 1)) * 128 + d]; }
        __syncthreads();
        f32x2 acc[8] = {};
#pragma unroll 4
        for (int d = 0; d < 128; ++d) { const f32x2 w2 = *(const f32x2*)(w_out + (size_t)(512 + g * 128 + d) * D + 2 * tid);
#pragma unroll
            for (int i = 0; i < 8; ++i) acc[i] += csl[i * 128 + d] * w2; }
#pragma unroll
        for (int h = 0; h < 2; ++h) { u32x4 o; o.x = pk2(acc[0][h], acc[1][h]); o.y = pk2(acc[2][h], acc[3][h]); o.z = pk2(acc[4][h], acc[5][h]); o.w = pk2(acc[6][h], acc[7][h]);
            *(u32x4*)(wout_t + (size_t)(2 * tid + h) * KO + 512 + g * 256 + 8 * kb) = o; }
        __syncthreads();
    }
    const int gw = bx * 8 + wave, NGW = G * 8;
    for (int row = gw; row < M + 512; row += NGW) {
        const float* src = row < M ? x + (size_t)row * D : ctx + (size_t)(row - M) * D;
        const float* mv = modv + (row < M ? (row >> 13) : 2) * 6144;
        f32x4 v[4]; float ss = 0.f;
#pragma unroll
        for (int j = 0; j < 4; ++j) { v[j] = ((const f32x4*)src)[lane + 64 * j]; ss += (v[j].x * v[j].x + v[j].y * v[j].y) + (v[j].z * v[j].z + v[j].w * v[j].w); }
        const float rs = rsqrtf(wave_sum(ss) * (1.f / D) + EPS);
#pragma unroll
        for (int j = 0; j < 4; ++j) { const int k = 4 * lane + 256 * j; const f32x4 gv = *(const f32x4*)(gmix + k), sh = *(const f32x4*)(mv + k), sc = *(const f32x4*)(mv + 1024 + k);
            const f32x4 o = (v[j] * rs * gv) * (1.f + sc) + sh; u32x2 w; w.x = pk2(o.x, o.y); w.y = pk2(o.z, o.w);
            *(u32x2*)(hl + (size_t)row * D + k) = w; }
    }
}
__device__ __forceinline__ void ctx_proj(const bf16* hc, const bf16* win_t, bf16* Kb, bf16* Vb, int bx, int G, int lane, int wave) {
    const int l16 = lane & 15, quad = lane >> 4;
    for (int u = bx; u < 256; u += G) {
        const int row = 32 * (u >> 4) + 16 * (wave >> 2) + l16, col = 64 * (u & 15) + 16 * (wave & 3) + l16;
        const bf16* ap = hc + (size_t)row * D + 8 * quad; const bf16* bp = win_t + (size_t)(512 + col) * D + 8 * quad;
        f32x4 acc = {0.f, 0.f, 0.f, 0.f};
#pragma unroll 8
        for (int s = 0; s < 32; ++s) acc = __builtin_amdgcn_mfma_f32_16x16x32_bf16(*(const bf16x8*)(ap + 32 * s), *(const bf16x8*)(bp + 32 * s), acc, 0, 0, 0);
#pragma unroll
        for (int j = 0; j < 4; ++j) { const int r = 32 * (u >> 4) + 16 * (wave >> 2) + 4 * quad + j, b = r >> 8, jr = r & 255;
            bf16* dst = col < 512 ? Kb : Vb; dst[((size_t)b * KV + jr) * 512 + (col & 511)] = (bf16)(pk2(acc[j], 0.f) & 0xffffu); }
    }
}
__device__ __forceinline__ void p5_router(const float* xl, const float* ssq, const float* gffn, const float* modv, const bf16* wrf, const float* brg, const float* bre,
                                          bf16* h2, unsigned* cnt, int* tokof, int* expid, int* posb, float* gate, LAS unsigned char* lds, int bx, int G, int tid, int lane, int wave) {
    const int l16 = lane & 15, quad = lane >> 4, grp = wave & 3, kh = wave >> 2;
    LAS float* LG = (LAS float*)lds;
    LAS int* hist = (LAS int*)(lds + 32768); LAS int* base = hist + 32;
    for (int tbk = bx; tbk < M / 64; tbk += G) {
        const int token = tbk * 64 + 16 * grp + l16, b = token >> 13; const float* mv = modv + b * 6144;
        float tot = 0.f;
#pragma unroll
        for (int q = 0; q < 4; ++q) { const f32x4 p = *(const f32x4*)(ssq + (size_t)token * 16 + 4 * q); tot += (p.x + p.y) + (p.z + p.w); }
        const float rs = rsqrtf(tot * (1.f / D) + EPS);
        f32x4 acc[3] = {};
        if (tid < 32) hist[tid] = 0;
#pragma unroll 2
        for (int s = kh * 16; s < kh * 16 + 16; ++s) { const int k0 = 32 * s + 8 * quad; float hv[8];
#pragma unroll
            for (int q = 0; q < 2; ++q) { const f32x4 xv = *(const f32x4*)(xl + (size_t)token * D + k0 + 4 * q), gv = *(const f32x4*)(gffn + k0 + 4 * q), sc = *(const f32x4*)(mv + 4096 + k0 + 4 * q), sh = *(const f32x4*)(mv + 3072 + k0 + 4 * q);
                const f32x4 o = (xv * rs * gv) * (1.f + sc) + sh; hv[4 * q] = o.x; hv[4 * q + 1] = o.y; hv[4 * q + 2] = o.z; hv[4 * q + 3] = o.w; }
            u32x4 hi, lo;
#pragma unroll
            for (int q = 0; q < 4; ++q) { const unsigned w = pk2(hv[2 * q], hv[2 * q + 1]); hi[q] = w;
                lo[q] = pk2(hv[2 * q] - __uint_as_float(w << 16), hv[2 * q + 1] - __uint_as_float(w & 0xffff0000u)); }
            *(u32x4*)(h2 + (size_t)token * D + k0) = hi;
            const bf16x8 ah = __builtin_bit_cast(bf16x8, hi), al = __builtin_bit_cast(bf16x8, lo);
#pragma unroll
            for (int nt = 0; nt < 3; ++nt) { const bf16x8 bh = *(const bf16x8*)(wrf + ((size_t)((s * 3 + nt) * 2 + 0) * 64 + lane) * 8), bl = *(const bf16x8*)(wrf + ((size_t)((s * 3 + nt) * 2 + 1) * 64 + lane) * 8);
                acc[nt] = __builtin_amdgcn_mfma_f32_16x16x32_bf16(ah, bh, acc[nt], 0, 0, 0);
                acc[nt] = __builtin_amdgcn_mfma_f32_16x16x32_bf16(ah, bl, acc[nt], 0, 0, 0);
                acc[nt] = __builtin_amdgcn_mfma_f32_16x16x32_bf16(al, bh, acc[nt], 0, 0, 0); } }
#pragma unroll
        for (int nt = 0; nt < 3; ++nt)
#pragma unroll
            for (int j = 0; j < 4; ++j) LG[((kh * 4 + grp) * 16 + 4 * quad + j) * 48 + 16 * nt + l16] = acc[nt][j];
        __syncthreads();
        int ex0 = 0, ex1 = 0, lp0 = 0, lp1 = 0; float g0 = 0.f, g1 = 0.f;
        if (tid < 64) {
            const LAS float* p0 = LG + (size_t)tid * 48; const LAS float* p1 = LG + (size_t)(64 + tid) * 48; float lg[36];
#pragma unroll
            for (int e = 0; e < 36; ++e) lg[e] = p0[e] + p1[e] + (e < 4 ? brg[e] : bre[e - 4]);
            int grpi = 0; float gm = lg[0];
#pragma unroll
            for (int i = 1; i < 4; ++i) if (lg[i] > gm) { gm = lg[i]; grpi = i; }
            float se = 0.f;
#pragma unroll
            for (int i = 0; i < 4; ++i) se += expf(lg[i] - gm);
            const float pg = 1.f / se;
            float el[8];
#pragma unroll
            for (int i = 0; i < 8; ++i) el[i] = grpi == 0 ? lg[4 + i] : (grpi == 1 ? lg[12 + i] : (grpi == 2 ? lg[20 + i] : lg[28 + i]));
            int i0 = 0; float v0 = el[0];
#pragma unroll
            for (int i = 1; i < 8; ++i) if (el[i] > v0) { v0 = el[i]; i0 = i; }
            int i1 = -1; float v1 = -3.0e38f;
#pragma unroll
            for (int i = 0; i < 8; ++i) if (i != i0 && el[i] > v1) { v1 = el[i]; i1 = i; }
            const float e1 = expf(v1 - v0); g0 = pg / (1.f + e1); g1 = pg * e1 / (1.f + e1);
            ex0 = grpi * 8 + i0; ex1 = grpi * 8 + i1;
            lp0 = __hip_atomic_fetch_add(hist + ex0, 1, __ATOMIC_RELAXED, __HIP_MEMORY_SCOPE_WORKGROUP); lp1 = __hip_atomic_fetch_add(hist + ex1, 1, __ATOMIC_RELAXED, __HIP_MEMORY_SCOPE_WORKGROUP);
        }
        __syncthreads();
        if (tid < 32) { const int n = hist[tid]; base[tid] = n > 0 ? (int)atomicAdd(&cnt[tid * 64], (unsigned)n) : 0; }
        __syncthreads();
        if (tid < 64) { const int tk = tbk * 64 + tid, q0 = base[ex0] + lp0, q1 = base[ex1] + lp1;
            tokof[ex0 * 16384 + q0] = tk; tokof[ex1 * 16384 + q1] = tk;
            expid[tk * 2] = ex0; expid[tk * 2 + 1] = ex1; posb[tk * 2] = q0; posb[tk * 2 + 1] = q1; gate[tk * 2] = g0; gate[tk * 2 + 1] = g1; }
        __syncthreads();
    }
}
__device__ __forceinline__ void p8_final(const bf16* ybuf, const int* expid, const int* posb, const float* gate, const float* modv, const float* gfin, float* out, const LAS int* tb, int bx, int G, int lane, int wave) {
    const int gw = bx * 8 + wave, NGW = G * 8;
    for (int row = gw; row < M; row += NGW) {
        const int e0 = expid[row * 2], e1 = expid[row * 2 + 1];
        const bf16* y0 = ybuf + (size_t)(tb[e0] * 256 + posb[row * 2]) * D; const bf16* y1 = ybuf + (size_t)(tb[e1] * 256 + posb[row * 2 + 1]) * D;
        const float g0 = gate[row * 2], g1 = gate[row * 2 + 1]; const float* gt2 = modv + (row >> 13) * 6144 + 5120;
        f32x4 v[4]; float ss = 0.f;
#pragma unroll
        for (int j = 0; j < 4; ++j) { const int k = 4 * lane + 256 * j; const f32x4 xv = *(const f32x4*)(out + (size_t)row * D + k), gv = *(const f32x4*)(gt2 + k);
            const u32x2 a = *(const u32x2*)(y0 + k), c = *(const u32x2*)(y1 + k);
            f32x4 ya = {__uint_as_float(a.x << 16), __uint_as_float(a.x & 0xffff0000u), __uint_as_float(a.y << 16), __uint_as_float(a.y & 0xffff0000u)};
            f32x4 yc = {__uint_as_float(c.x << 16), __uint_as_float(c.x & 0xffff0000u), __uint_as_float(c.y << 16), __uint_as_float(c.y & 0xffff0000u)};
            v[j] = xv + gv * (g0 * ya + g1 * yc); ss += (v[j].x * v[j].x + v[j].y * v[j].y) + (v[j].z * v[j].z + v[j].w * v[j].w); }
        const float rs = rsqrtf(wave_sum(ss) * (1.f / D) + EPS);
#pragma unroll
        for (int j = 0; j < 4; ++j) { const int k = 4 * lane + 256 * j; *(f32x4*)(out + (size_t)row * D + k) = v[j] * rs * *(const f32x4*)(gfin + k); }
    }
}
}
struct Args { const float* in[24]; float* out; unsigned char* ws; int ph_lo, ph_hi, li, pad; };
__global__ void __launch_bounds__(NWAVES * 64, 2) mk_fwd(Args args) {
    extern __shared__ __attribute__((aligned(16))) unsigned char lds_raw[];
    LAS unsigned char* lds = (LAS unsigned char*)lds_raw;
    volatile LAS unsigned* MISC = (volatile LAS unsigned*)(lds + MISC_OFF);
    const int tid = threadIdx.x, lane = tid & 63, wave = __builtin_amdgcn_readfirstlane(tid >> 6);
    const int G = gridDim.x, bx = blockIdx.x;
    unsigned char* ws = args.ws;
    unsigned* ctl = (unsigned*)(ws + WS_CTL);
    if (tid < 32) MISC[tid] = 0u;
    __syncthreads();
    const int lo = args.ph_lo, hi = args.ph_hi;
    XcdBarrier bar; bar.bar = ctl + CW_BAR + args.li * XCD_BAR_WORDS; bar.x = 0; bar.st = nullptr;
    if (hi - lo > 1) bar = xcd_barrier_post(ctl + CW_BAR + args.li * XCD_BAR_WORDS, MISC + 8);
#ifndef PH_ENABLE
#define PH_ENABLE 0x1FF
#endif
#define IN(k) (((PH_ENABLE >> (k)) & 1) && lo <= (k) && (k) < hi)
#define SEAM(k) do { if (IN(k) && IN((k) + 1)) xcd_barrier(bar); } while (0)
    bf16* win_t = (bf16*)(ws + WS_WIN_T); bf16* wout_t = (bf16*)(ws + WS_WOUT_T); bf16* wgu = (bf16*)(ws + WS_WGU); bf16* wd = (bf16*)(ws + WS_WD);
    bf16* hl = (bf16*)(ws + WS_HL); bf16* amix = (bf16*)(ws + WS_AMIX); bf16* ybuf = (bf16*)(ws + WS_YBUF);
    bf16* Q = (bf16*)(ws + WS_Q); bf16* Kb = (bf16*)(ws + WS_K); bf16* Vb = (bf16*)(ws + WS_V); bf16* F = (bf16*)(ws + WS_F);
    bf16* h2 = (bf16*)(ws + WS_H2); bf16* hmid = (bf16*)(ws + WS_HMID);
    float* modv = (float*)(ws + WS_MOD); float* rope = (float*)(ws + WS_ROPE); float* ssq = (float*)(ws + WS_SSQ);
    float* xl = args.out;

    int* tokof = (int*)(ws + WS_TOKOF); int* expid = (int*)(ws + WS_RT); int* posb = expid + M * 2; float* gate = (float*)(posb + M * 2);
    unsigned* cnt = ctl + CW_CNT;
    if (IN(0)) {
        thin::P0Args a{args.in[1], args.in[3], args.in[4], args.in[5], args.in[8], args.in[15], args.in[20], args.in[21], args.in[22], args.in[14], args.in[16], args.in[18],
                       modv, rope, (float*)(ws + WS_CS), (bf16*)(ws + WS_F1T), (float2*)(ws + WS_TW), (bf16*)(ws + WS_F2P), (bf16*)(ws + WS_WRF), win_t, wout_t, wgu, wd};
        thin::p0_prologue(a, lds + RING_OFF, bx, G, tid, lane, wave);
    }
    SEAM(0);
    if (IN(1)) thin::p1_norms(args.in[0], args.in[2], args.in[6], modv, hl, (const float*)(ws + WS_CS), args.in[15], wout_t, lds + RING_OFF, bx, G, tid, lane, wave);
    SEAM(1);
    if (IN(2)) {
        thin::ctx_proj(hl + (size_t)M * D, win_t, Kb, Vb, bx, G, lane, wave);
        pg8::Gemm g{hl, win_t, M, 2048, D}; pg8::StaticOrder S; S.init(M, 2048, G, bx);
        pg8::EpiInProj E{Q, Kb, Vb, F, rope};
        pg8::gemm_phase<pg8::EpiInProj, pg8::StaticOrder, true, true>(lds + RING_OFF, g, S, E);
    }
    SEAM(2);
    if (IN(3)) {
        const float* lq1 = args.in[9]; const float* lk1 = args.in[10]; const float* lq2 = args.in[11]; const float* lk2 = args.in[12]; const float* gsub = args.in[13];
        float a1 = lq1[lane] * lk1[lane], a2 = lq2[lane] * lk2[lane];
#pragma unroll
        for (int o = 1; o < 64; o <<= 1) { a1 += __shfl_xor(a1, o); a2 += __shfl_xor(a2, o); }
        const float lam = expf(a1) - expf(a2) + 0.2f;
        float gs[4];
#pragma unroll
        for (int d0 = 0; d0 < 4; ++d0) gs[d0] = gsub[32 * d0 + (lane & 31)] * 0.8f;
        const unsigned lds0 = (unsigned)(uintptr_t)lds_raw + RING_OFF;
        if (!(args.pad & 1)) for (int u = bx; u < 512; u += G) { const int bh = u & 7, qb = u >> 3, b = bh >> 2, h = bh & 3;
            da::attn_unit<0>(Q + ((size_t)b * S + qb * 128) * 512 + h * 128, Kb + (size_t)b * KV * 512 + h * 128, Vb + (size_t)b * KV * 512 + h * 128,
                          amix + ((size_t)b * S + qb * 128) * KO + h * 128, KO, KV, lds + RING_OFF, lds0, lam, gs); }
        if (!(args.pad & 2)) for (int u = bx; u < 256; u += G) { const int b = u >> 7, g = (u >> 5) & 3, cq = u & 31;
            fft::fft_unit(F + (size_t)u * S * 4, amix + (size_t)b * S * KO + 512 + g * 256 + cq * 8, KO, (const bf16*)(ws + WS_F1T), (const float2*)(ws + WS_TW), (const bf16*)(ws + WS_F2P), lds + RING_OFF); }
    }
    SEAM(3);
    if (IN(4)) {
        pg8::Gemm g{amix, wout_t, M, D, KO}; pg8::StaticOrder S; S.init(M, D, G, bx);
        pg8::EpiOut E{args.in[0], modv, xl, ssq};
        pg8::gemm_phase<pg8::EpiOut, pg8::StaticOrder, true, true>(lds + RING_OFF, g, S, E);
    }
    SEAM(4);
    if (IN(5)) thin::p5_router(xl, ssq, args.in[7], modv, (const bf16*)(ws + WS_WRF), args.in[17], args.in[19], h2, cnt, tokof, expid, posb, gate, lds + RING_OFF, bx, G, tid, lane, wave);
    SEAM(5);
    if (IN(6) || IN(7) || IN(8)) {
        LAS int* tb = (LAS int*)(lds + TB_OFF); LAS int* toks = (LAS int*)(lds + TOKS_OFF);
        if (tid == 0) { int a = 0; for (int e = 0; e < NEXP; ++e) { tb[e] = a; a += ((int)cnt[e * 64] + 255) >> 8; } tb[NEXP] = a; }
        __syncthreads();
        pg8::MoeOrder S{tb[NEXP] * 4, G, bx, tb, toks};
        if (IN(6)) {
            for (int i = 0; i < 4; ++i) { pg8::Unit u; if (!S.next(i, u)) break;
                const int e = u.pn >> 2, pos = (u.pm - tb[e]) * 256 + tid;
                if (tid < 256) toks[i * 256 + tid] = pos < (int)cnt[e * 64] ? tokof[e * 16384 + pos] : 0; }
            __syncthreads();
            pg8::Gemm g{h2, wgu, MAXSLOT, 1024, D};
            pg8::EpiGateUp E{hmid};
            pg8::gemm_phase<pg8::EpiGateUp, pg8::MoeOrder, true, true, true>(lds + RING_OFF, g, S, E);
        }
        SEAM(6);
        if (IN(7)) {
            pg8::Gemm g{hmid, wd, MAXSLOT, 1024, DE};
            pg8::EpiDown E{ybuf};
            pg8::gemm_phase<pg8::EpiDown, pg8::MoeOrder, true, true, false>(lds + RING_OFF, g, S, E);
        }
        SEAM(7);
        if (IN(8)) thin::p8_final(ybuf, expid, posb, gate, modv, args.in[23], args.out, tb, bx, G, lane, wave);
    }
#undef IN
#undef SEAM
}


#if defined(ATT_PROBE)
__global__ void __launch_bounds__(NWAVES * 64, 2) probe_attn(Args args) {
    extern __shared__ __attribute__((aligned(16))) unsigned char lds_raw[];
    LAS unsigned char* lds = (LAS unsigned char*)lds_raw;
    const int tid = threadIdx.x, lane = tid & 63; const int G = gridDim.x, bx = blockIdx.x;
    unsigned char* ws = args.ws;
    bf16* amix = (bf16*)(ws + WS_AMIX); bf16* Q = (bf16*)(ws + WS_Q); bf16* Kb = (bf16*)(ws + WS_K); bf16* Vb = (bf16*)(ws + WS_V);
    for (int i = tid; i < RING_BYTES / 4; i += 512) ((LAS unsigned*)lds)[i] = 0u;
    __syncthreads();
    float gs[4] = {1.f, 1.f, 1.f, 1.f};
    const unsigned lds0 = (unsigned)(uintptr_t)lds_raw + RING_OFF;
    for (int u = bx; u < 512; u += G) { const int bh = u & 7, qb = u >> 3, b = bh >> 2, h = bh & 3;
        da::attn_unit<ATT_PROBE>(Q + ((size_t)b * S + qb * 128) * 512 + h * 128, Kb + (size_t)b * KV * 512 + h * 128, Vb + (size_t)b * KV * 512 + h * 128,
                      amix + ((size_t)b * S + qb * 128) * KO + h * 128, KO, KV, lds + RING_OFF, lds0, 0.2f, gs); }
}
#endif
#define ONE_LAUNCH 1
#ifndef OPT_MASK
#define OPT_MASK 0x3FF
#endif
static void launch_phases(const Args& base, int lo, int hi, int li, int grid, hipStream_t stream, int flags = 0) {
    Args a = base; a.ph_lo = lo; a.ph_hi = hi; a.li = li; a.pad = flags;
    hipLaunchKernelGGL(mk_fwd, dim3(grid), dim3(NWAVES * 64), LDS_BYTES, stream, a);
    const hipError_t le = hipPeekAtLastError();
    if (le != hipSuccess) fprintf(stderr, "kernel_launch: mk_fwd [%d,%d) failed: %s\n", lo, hi, hipGetErrorName(le));
}
extern "C" void kernel_launch(void* const* d_in, const int* in_sizes, int n_in, void* d_out, int out_size, void* d_ws, size_t ws_size, hipStream_t stream) {
    static int ok = 0; static int grid_g = 256;
    if (ok == 0) {
        if (n_in != 24 || in_sizes[0] != M * D || out_size != M * D || ws_size < WS_END) { fprintf(stderr, "kernel_launch: shape/ws mismatch n_in %d in0 %d out %d ws %zu (need %zu)\n", n_in, n_in > 0 ? in_sizes[0] : -1, out_size, ws_size, (size_t)WS_END); ok = -1; return; }
        hipFuncSetAttribute((const void*)k_attn, hipFuncAttributeMaxDynamicSharedMemorySize, (2 * KV + 128 + 8 + 256) * 4);
        hipFuncSetAttribute((const void*)k_fft, hipFuncAttributeMaxDynamicSharedMemorySize, 2 * 8192 * 4 + S * 4 * 2);
        if (hipFuncSetAttribute((const void*)mk_fwd, hipFuncAttributeMaxDynamicSharedMemorySize, LDS_BYTES) != hipSuccess) { fprintf(stderr, "kernel_launch: hipFuncSetAttribute(mk_fwd) failed\n"); ok = -1; return; }
        int dev = 0, cus = 0, per_cu = 0;
        hipGetDevice(&dev); hipDeviceGetAttribute(&cus, hipDeviceAttributeMultiprocessorCount, dev);
        hipOccupancyMaxActiveBlocksPerMultiprocessor(&per_cu, (const void*)mk_fwd, NWAVES * 64, LDS_BYTES);
        if (per_cu < 1 || cus != 256) fprintf(stderr, "kernel_launch: note: occupancy %d blocks/CU, %d CUs\n", per_cu, cus);
        (void)hipGetLastError();
        grid_g = cus;
        ok = 1;
    }
    if (ok < 0) return;
    const float* x = (const float*)d_in[0]; const float* c = (const float*)d_in[1]; const float* ctx = (const float*)d_in[2]; const float* cctx = (const float*)d_in[3];
    const float* w_ada = (const float*)d_in[4]; const float* b_ada = (const float*)d_in[5]; const float* gmix = (const float*)d_in[6]; const float* gffn = (const float*)d_in[7];
    const float* w_in = (const float*)d_in[8]; const float* lq1 = (const float*)d_in[9]; const float* lk1 = (const float*)d_in[10]; const float* lq2 = (const float*)d_in[11]; const float* lk2 = (const float*)d_in[12];
    const float* gsub = (const float*)d_in[13]; const float* wfour = (const float*)d_in[14]; const float* w_out = (const float*)d_in[15];
    const float* wrg = (const float*)d_in[16]; const float* brg = (const float*)d_in[17]; const float* wre = (const float*)d_in[18]; const float* bre = (const float*)d_in[19];
    const float* w_gate = (const float*)d_in[20]; const float* w_up = (const float*)d_in[21]; const float* w_down = (const float*)d_in[22]; const float* gfin = (const float*)d_in[23];
    unsigned char* ws = (unsigned char*)d_ws; float* out = (float*)d_out;
    unsigned* ctl = (unsigned*)(ws + WS_CTL); float* modv = (float*)(ws + WS_MOD); float* rope = (float*)(ws + WS_ROPE); float* cs = (float*)(ws + WS_CS);
    int* expid = (int*)(ws + WS_RT); int* posb = expid + M * 2; float* gate = (float*)(posb + M * 2);
    int* tokof = (int*)(ws + WS_TOKOF);
    bf16* win_t = (bf16*)(ws + WS_WIN_T); bf16* wout_t = (bf16*)(ws + WS_WOUT_T); bf16* wgu = (bf16*)(ws + WS_WGU); bf16* wd = (bf16*)(ws + WS_WD);
    bf16* hl = (bf16*)(ws + WS_HL); bf16* hc = (bf16*)(ws + WS_HC); bf16* amix = (bf16*)(ws + WS_AMIX); bf16* ybuf = (bf16*)(ws + WS_YBUF);
    bf16* Q = (bf16*)(ws + WS_Q); bf16* Kb = (bf16*)(ws + WS_K); bf16* Vb = (bf16*)(ws + WS_V); bf16* F = (bf16*)(ws + WS_F);
    bf16* h2 = (bf16*)(ws + WS_H2); bf16* hmid = (bf16*)(ws + WS_HMID);
    float* xl = out;
    Args base{}; for (int i = 0; i < 24; ++i) base.in[i] = (const float*)d_in[i]; base.out = out; base.ws = ws;
    hipMemsetAsync(ws + WS_CTL, 0, CTL_ZERO_BYTES, stream);
#if defined(ONE_LAUNCH)
    launch_phases(base, 0, 9, 0, grid_g, stream);
#if defined(ATT_PROBE)
    { Args a = base; a.ph_lo = 0; a.ph_hi = 0; a.li = 1; a.pad = 0; hipFuncSetAttribute((const void*)probe_attn, hipFuncAttributeMaxDynamicSharedMemorySize, LDS_BYTES); hipLaunchKernelGGL(probe_attn, dim3(grid_g), dim3(NWAVES * 64), LDS_BYTES, stream, a); }
#endif
#else
    if (OPT_MASK & 1) launch_phases(base, 0, 1, 0, grid_g, stream);
    else {
    k_mod<<<dim3(6144 / 256, 3), 256, 0, stream>>>(c, cctx, w_ada, b_ada, modv);
    k_tables<<<8, 256, 0, stream>>>(rope);
    k_fft_tables<<<128, 256, 0, stream>>>((bf16*)(ws + WS_F1T), (float2*)(ws + WS_TW), (bf16*)(ws + WS_F2P));
    k_cvtT<<<dim3(D * 2048 / 256, 1), 256, 0, stream>>>(w_in, D, 2048, 0, win_t, D, 0, 0, 0);
    k_cvtT<<<dim3(512 * D / 256, 1), 256, 0, stream>>>(w_out, 512, D, 0, wout_t, KO, 0, 0, 0);
    k_cvtT<<<dim3(D * DE / 256, NEXP), 256, 0, stream>>>(w_gate, D, DE, (size_t)D * DE, wgu, D, 0, (size_t)1024 * D, 1);
    k_cvtT<<<dim3(D * DE / 256, NEXP), 256, 0, stream>>>(w_up, D, DE, (size_t)D * DE, wgu, D, 0, (size_t)1024 * D, 2);
    k_cvtT<<<dim3(DE * D / 256, NEXP), 256, 0, stream>>>(w_down, DE, D, (size_t)DE * D, wd, DE, 0, (size_t)1024 * DE, 0);
    k_fold1<<<4 * 2 * 128 * 128 / 256, 256, 0, stream>>>(wfour, cs);
    }
    if (OPT_MASK & 2) launch_phases(base, 1, 2, 0, grid_g, stream);
    else { k_fold2<<<dim3(D / 256, 1024), 256, 0, stream>>>(cs, w_out, wout_t); k_normmod<<<M + 512, 256, 0, stream>>>(x, ctx, gmix, modv, hl); }
    if (OPT_MASK & 4) launch_phases(base, 2, 3, 0, grid_g, stream);
    else { PInProj p{hl, win_t, rope, Q, Kb, Vb, F, D}; k_gemm<PInProj><<<dim3(2048 / 64, M / 64), 256, 0, stream>>>(p);
           PCtx p2{hc, win_t, Kb, Vb, D}; k_gemm<PCtx><<<dim3(1024 / 64, 512 / 64), 256, 0, stream>>>(p2); }
    if ((OPT_MASK & 8) || (OPT_MASK & 0x200)) launch_phases(base, 3, 4, 0, grid_g, stream, ((OPT_MASK & 8) ? 0 : 1) | ((OPT_MASK & 0x200) ? 0 : 2));
    if (!(OPT_MASK & 8)) k_attn<<<dim3(M, NH), 256, (2 * KV + 128 + 8 + 256) * 4, stream>>>(Q, Kb, Vb, amix, lq1, lk1, lq2, lk2, gsub);
    if (!(OPT_MASK & 0x200)) k_fft<<<dim3(128, 256), 256, 2 * 8192 * 4 + S * 4 * 2, stream>>>(F, amix);
    if (OPT_MASK & 16) launch_phases(base, 4, 5, 0, grid_g, stream);
    else { POut p{amix, wout_t, x, modv, xl, KO}; k_gemm<POut><<<dim3(D / 64, M / 64), 256, 0, stream>>>(p); }
    if (OPT_MASK & 32) launch_phases(base, 5, 6, 0, grid_g, stream);
    else k_router<<<M, 256, 0, stream>>>(xl, gffn, modv, wrg, brg, wre, bre, h2, ctl + CW_CNT, tokof, expid, posb, gate, (OPT_MASK & 16) ? (const float*)(ws + WS_SSQ) : nullptr);
    if (OPT_MASK & 64) launch_phases(base, 6, 7, 0, grid_g, stream);
    else { PGateUp p{h2, wgu, ctl + CW_CNT, tokof, hmid, D, 0, 0, 0}; k_gemm<PGateUp><<<dim3(1024 / 64, 256, NEXP), 256, 0, stream>>>(p); }
    if (OPT_MASK & 128) launch_phases(base, 7, 8, 0, grid_g, stream);
    else { PDown p{hmid, wd, ctl + CW_CNT, ybuf, DE, 0, 0, 0}; k_gemm<PDown><<<dim3(1024 / 64, 256, NEXP), 256, 0, stream>>>(p); }
    if (OPT_MASK & 256) launch_phases(base, 8, 9, 0, grid_g, stream);
    else k_final<<<M, 256, 0, stream>>>(xl, ybuf, ctl + CW_CNT, expid, posb, gate, modv, gfin, out);
#endif
}
```

```cpp
#include <hip/hip_runtime.h>
#include <cstdint>
#include <cstdio>

typedef unsigned short bf16;
constexpr int NB = 2, S = 8192, D = 1024, M = NB * S, CTX = 256, KV = CTX + S, NH = 4, NEXP = 32, DE = 512;
constexpr int KO = 1536;
constexpr float EPS = 1e-6f;
constexpr float C2 = 0.125f * 1.4426950408889634f;
constexpr int MAXSLOT = 40960;

constexpr size_t MiB = 1u << 20;
constexpr size_t WS_CTL = 0, CTL_ZERO_BYTES = 1 * MiB;
constexpr size_t WS_MOD = 1 * MiB;
constexpr size_t WS_ROPE = WS_MOD + 128 * 1024;
constexpr size_t WS_CS = WS_ROPE + 64 * 1024;
constexpr size_t WS_F1T = WS_CS + 512 * 1024;
constexpr size_t WS_TW = WS_F1T + 64 * 1024;
constexpr size_t WS_F2P = WS_TW + 64 * 1024;
constexpr size_t WS_RT = 2 * MiB;
constexpr size_t WS_TOKOF = 3 * MiB;
constexpr size_t WS_WRF = 5 * MiB;
constexpr size_t WS_SSQ = 7 * MiB;
constexpr size_t WS_WIN_T = 8 * MiB;
constexpr size_t WS_WOUT_T = 12 * MiB;
constexpr size_t WS_WGU = 16 * MiB;
constexpr size_t WS_WD = 80 * MiB;
constexpr size_t WS_C = 112 * MiB;
constexpr size_t WS_D = 192 * MiB;
constexpr size_t WS_END = 264 * MiB;
constexpr size_t WS_HL = WS_C, WS_HC = WS_C + (size_t)M * D * 2, WS_AMIX = WS_C, WS_YBUF = WS_C;
constexpr size_t WS_Q = WS_D, WS_K = WS_Q + (size_t)M * 512 * 2, WS_V = WS_K + (size_t)NB * KV * 512 * 2, WS_F = WS_V + (size_t)NB * KV * 512 * 2;
constexpr size_t WS_H2 = WS_D, WS_HMID = WS_D + (size_t)M * D * 2;
static_assert(WS_F + (size_t)M * 512 * 2 <= WS_END && WS_HMID + (size_t)MAXSLOT * DE * 2 <= WS_END, "region D");
constexpr int CW_CNT = 1024;

__device__ __forceinline__ float bf2f(bf16 v) { return __uint_as_float((unsigned)v << 16); }
__device__ __forceinline__ bf16 f2bf(float f) { unsigned u = __float_as_uint(f); return (bf16)((u + 0x7fffu + ((u >> 16) & 1u)) >> 16); }

__global__ void k_mod(const float* c, const float* cctx, const float* w_ada, const float* b_ada, float* modv) {
    const int v = blockIdx.y, j = blockIdx.x * 256 + threadIdx.x;
    const float* cv = v < 2 ? c + v * D : cctx;
    float acc = b_ada[j];
    for (int k = 0; k < D; ++k) { const float s = cv[k]; acc += (s / (1.f + expf(-s))) * w_ada[(size_t)k * 6144 + j]; }
    modv[v * 6144 + j] = acc;
}
__global__ void k_tables(float* rope) {
    const int t = blockIdx.x * 256 + threadIdx.x; if (t >= 128 * 16) return;
    const int pos = t >> 4, i = t & 15;
    const float inv = powf(10000.f, -(float)(2 * i) / 32.f), ang = (float)pos * inv;
    rope[t] = cosf(ang); rope[2048 + t] = sinf(ang);
}
__global__ void k_cvtT(const float* in, int K, int N, size_t istr, bf16* out, int ldo, int coloff, size_t ostr, int mode) {
    const size_t i = (size_t)blockIdx.x * 256 + threadIdx.x; if (i >= (size_t)K * N) return;
    const int e = blockIdx.y; const int k = (int)(i / N), n = (int)(i % N);
    int r = n;
    if (mode == 1) r = (n >> 4) * 32 + (n & 15); else if (mode == 2) r = (n >> 4) * 32 + 16 + (n & 15);
    out[e * ostr + (size_t)r * ldo + coloff + k] = f2bf(in[e * istr + i]);
}
__global__ void k_fft_tables(bf16* f1t, float2* tw, bf16* f2p) {
    const int t = blockIdx.x * 256 + threadIdx.x;
    if (t < 2 * 128 * 128) { const int part = t >> 14, k1 = (t >> 7) & 127, n1 = t & 127; const float x = (float)((k1 * n1) & 127) / 64.f; f1t[t] = f2bf(part ? -sinpif(x) : cospif(x)); }
    if (t < 64 * 128) { const int n2 = t >> 7, k1 = t & 127; const float x = (float)(n2 * k1) / 4096.f; tw[t] = make_float2(cospif(x), -sinpif(x)); }
    if (t < 3 * 64 * 64) { const int tab = t >> 12, k2 = (t >> 6) & 63, pos = t & 63, sp = pos >> 5, quad = (pos >> 3) & 3, jj = pos & 7;
        const int n2 = 32 * sp + (jj < 4 ? 4 * quad + jj : 16 + 4 * quad + (jj - 4)); const float x = (float)((n2 * k2) & 63) / 32.f;
        f2p[t] = f2bf(tab == 0 ? cospif(x) : (tab == 1 ? sinpif(x) : -sinpif(x))); }
}
__global__ void k_fold1(const float* wf, float* cs) {
    const int t = blockIdx.x * 256 + threadIdx.x;
    const int d = t & 127, c = (t >> 7) & 127, part = (t >> 14) & 1, g = t >> 15;
    float acc = 0.f;
    for (int kap = 0; kap < 128; ++kap) { const float x = (float)((c * kap) & 127) / 64.f; const float tr = part ? sinpif(x) : cospif(x); acc += tr * wf[((size_t)g * 128 + kap) * 128 + d]; }
    cs[t] = acc * (1.0f / 1024.0f);
}
__global__ void k_fold2(const float* cs, const float* w_out, bf16* wout_t) {
    const int n = blockIdx.x * 256 + threadIdx.x, kf = blockIdx.y;
    const int g = kf >> 8, c = (kf >> 1) & 127, part = kf & 1;
    const float* csr = cs + (((size_t)g * 2 + part) * 128 + c) * 128;
    float acc = 0.f;
    for (int d = 0; d < 128; ++d) acc += csr[d] * w_out[(size_t)(512 + g * 128 + d) * D + n];
    wout_t[(size_t)n * KO + 512 + kf] = f2bf(acc);
}
__device__ __forceinline__ float block_sum(float v, float* red) {
    for (int o = 1; o < 64; o <<= 1) v += __shfl_xor(v, o);
    __syncthreads(); if ((threadIdx.x & 63) == 0) red[threadIdx.x >> 6] = v; __syncthreads();
    float s = 0.f; for (int w = 0; w < (int)(blockDim.x >> 6); ++w) s += red[w]; return s;
}
__device__ __forceinline__ float block_max(float v, float* red) {
    for (int o = 1; o < 64; o <<= 1) v = fmaxf(v, __shfl_xor(v, o));
    __syncthreads(); if ((threadIdx.x & 63) == 0) red[threadIdx.x >> 6] = v; __syncthreads();
    float s = red[0]; for (int w = 1; w < (int)(blockDim.x >> 6); ++w) s = fmaxf(s, red[w]); return s;
}
__global__ void k_normmod(const float* x, const float* ctx, const float* g, const float* modv, bf16* hl) {
    __shared__ float red[8];
    const int row = blockIdx.x, t = threadIdx.x;
    const float* src = row < M ? x + (size_t)row * D : ctx + (size_t)(row - M) * D;
    const float* mv = modv + (row < M ? (row / S) : 2) * 6144;
    float v[4], ss = 0.f;
    for (int j = 0; j < 4; ++j) { v[j] = src[t + 256 * j]; ss += v[j] * v[j]; }
    const float rs = rsqrtf(block_sum(ss, red) / D + EPS);
    for (int j = 0; j < 4; ++j) { const int k = t + 256 * j; hl[(size_t)row * D + k] = f2bf((v[j] * rs * g[k]) * (1.f + mv[1024 + k]) + mv[k]); }
}

template <class P> __global__ __launch_bounds__(256) void k_gemm(P p) {
    __shared__ float As[32][65], Bs[32][65];
    __shared__ int sb_sh[2];
    if (!p.init(sb_sh)) return;
    const int tid = threadIdx.x, tx = tid & 15, ty = tid >> 4;
    const int lr = tid >> 2, lk = (tid & 3) * 8;
    const bf16* ar = p.arow(lr); const bf16* br = p.brow(lr);
    float acc[4][4] = {};
    for (int k0 = 0; k0 < p.K; k0 += 32) {
        const uint4 av = *(const uint4*)(ar + k0 + lk), bv = *(const uint4*)(br + k0 + lk);
        const unsigned aw[4] = {av.x, av.y, av.z, av.w}, bw[4] = {bv.x, bv.y, bv.z, bv.w};
        __syncthreads();
        for (int i = 0; i < 4; ++i) { As[lk + 2 * i][lr] = __uint_as_float(aw[i] << 16); As[lk + 2 * i + 1][lr] = __uint_as_float(aw[i] & 0xffff0000u);
                                      Bs[lk + 2 * i][lr] = __uint_as_float(bw[i] << 16); Bs[lk + 2 * i + 1][lr] = __uint_as_float(bw[i] & 0xffff0000u); }
        __syncthreads();
        for (int kk = 0; kk < 32; ++kk) { float a[4], b[4];
            for (int i = 0; i < 4; ++i) { a[i] = As[kk][ty + 16 * i]; b[i] = Bs[kk][tx + 16 * i]; }
            for (int i = 0; i < 4; ++i) for (int j = 0; j < 4; ++j) acc[i][j] += a[i] * b[j]; }
    }
    p.epi(ty, tx, acc);
}
struct PInProj {
    const bf16* hl; const bf16* wt; const float* rope; bf16 *Q, *Kb, *Vb, *F; int K;
    __device__ bool init(int*) { return true; }
    __device__ const bf16* arow(int r) const { return hl + (size_t)(blockIdx.y * 64 + r) * D; }
    __device__ const bf16* brow(int n) const { return wt + (size_t)(blockIdx.x * 64 + n) * D; }
    __device__ void epi(int ty, int tx, float (&acc)[4][4]) const {
        const int tn = blockIdx.x * 64, sec = tn >> 9;
        for (int i = 0; i < 4; ++i) { const int row = blockIdx.y * 64 + ty + 16 * i, b = row / S, s = row % S; float o[4];
            if (sec < 2) { const int p0 = s >> 6, p1 = s & 63; const float c0 = rope[p0 * 16 + tx], s0 = rope[2048 + p0 * 16 + tx], c1 = rope[p1 * 16 + tx], s1 = rope[2048 + p1 * 16 + tx];
                o[0] = acc[i][0] * c0 - acc[i][1] * s0; o[1] = acc[i][1] * c0 + acc[i][0] * s0; o[2] = acc[i][2] * c1 - acc[i][3] * s1; o[3] = acc[i][3] * c1 + acc[i][2] * s1;
            } else for (int j = 0; j < 4; ++j) o[j] = acc[i][j];
            for (int j = 0; j < 4; ++j) { const int col = (tn & 511) + tx + 16 * j;
                if (sec == 0) Q[(size_t)row * 512 + col] = f2bf(o[j] * C2);
                else if (sec == 1) Kb[((size_t)b * KV + CTX + s) * 512 + col] = f2bf(o[j]);
                else if (sec == 2) Vb[((size_t)b * KV + CTX + s) * 512 + col] = f2bf(o[j]);
                else { const int g = col >> 7, c = col & 127; F[((((size_t)b * 4 + g) * 32 + (c >> 2)) * S + s) * 4 + (c & 3)] = f2bf(o[j]); } } }
    }
};
struct PCtx {
    const bf16* hc; const bf16* wt; bf16 *Kb, *Vb; int K;
    __device__ bool init(int*) { return true; }
    __device__ const bf16* arow(int r) const { return hc + (size_t)(blockIdx.y * 64 + r) * D; }
    __device__ const bf16* brow(int n) const { return wt + (size_t)(512 + blockIdx.x * 64 + n) * D; }
    __device__ void epi(int ty, int tx, float (&acc)[4][4]) const {
        for (int i = 0; i < 4; ++i) { const int row = blockIdx.y * 64 + ty + 16 * i, b = row / CTX, j0 = row % CTX;
            for (int j = 0; j < 4; ++j) { const int col = blockIdx.x * 64 + tx + 16 * j; bf16* dst = col < 512 ? Kb : Vb;
                dst[((size_t)b * KV + j0) * 512 + (col & 511)] = f2bf(acc[i][j]); } }
    }
};
struct POut {
    const bf16* amix; const bf16* wt; const float* x; const float* modv; float* xl; int K;
    __device__ bool init(int*) { return true; }
    __device__ const bf16* arow(int r) const { return amix + (size_t)(blockIdx.y * 64 + r) * KO; }
    __device__ const bf16* brow(int n) const { return wt + (size_t)(blockIdx.x * 64 + n) * KO; }
    __device__ void epi(int ty, int tx, float (&acc)[4][4]) const {
        for (int i = 0; i < 4; ++i) { const int row = blockIdx.y * 64 + ty + 16 * i, b = row / S;
            for (int j = 0; j < 4; ++j) { const int col = blockIdx.x * 64 + tx + 16 * j; xl[(size_t)row * D + col] = x[(size_t)row * D + col] + modv[b * 6144 + 2048 + col] * acc[i][j]; } }
    }
};
__device__ __forceinline__ int slot_base(const unsigned* cnt, int e) { int sb = 0; for (int i = 0; i < e; ++i) sb += ((int)cnt[i * 64] + 255) >> 8; return sb * 256; }
struct PGateUp {
    const bf16* h2; const bf16* wgu; const unsigned* cnt; const int* tokof; bf16* hmid; int K; int e, n, sb;
    __device__ bool init(int* sh) { e = blockIdx.z; n = (int)cnt[e * 64]; if ((int)blockIdx.y * 64 >= n) return false;
        if (threadIdx.x == 0) sh[0] = slot_base(cnt, e); __syncthreads(); sb = sh[0]; return true; }
    __device__ const bf16* arow(int r) const { const int pos = blockIdx.y * 64 + r; const int tok = pos < n ? tokof[e * 16384 + pos] : 0; return h2 + (size_t)tok * D; }
    __device__ const bf16* brow(int nn) const { return wgu + ((size_t)e * 1024 + blockIdx.x * 64 + nn) * D; }
    __device__ void epi(int ty, int tx, float (&acc)[4][4]) const {
        for (int i = 0; i < 4; ++i) { const int pos = blockIdx.y * 64 + ty + 16 * i; if (pos >= n) continue;
            for (int jj = 0; jj < 2; ++jj) { const float gte = acc[i][2 * jj], up = acc[i][2 * jj + 1]; const int hc = (blockIdx.x * 2 + jj) * 16 + tx;
                hmid[(size_t)(sb + pos) * DE + hc] = f2bf((gte / (1.f + expf(-gte))) * up); } }
    }
};
struct PDown {
    const bf16* hmid; const bf16* wd; const unsigned* cnt; bf16* ybuf; int K; int e, n, sb;
    __device__ bool init(int* sh) { e = blockIdx.z; n = (int)cnt[e * 64]; if ((int)blockIdx.y * 64 >= n) return false;
        if (threadIdx.x == 0) sh[0] = slot_base(cnt, e); __syncthreads(); sb = sh[0]; return true; }
    __device__ const bf16* arow(int r) const { const int pos = blockIdx.y * 64 + r; return hmid + (size_t)(sb + (pos < n ? pos : 0)) * DE; }
    __device__ const bf16* brow(int nn) const { return wd + ((size_t)e * 1024 + blockIdx.x * 64 + nn) * DE; }
    __device__ void epi(int ty, int tx, float (&acc)[4][4]) const {
        for (int i = 0; i < 4; ++i) { const int pos = blockIdx.y * 64 + ty + 16 * i; if (pos >= n) continue;
            for (int j = 0; j < 4; ++j) ybuf[(size_t)(sb + pos) * D + blockIdx.x * 64 + tx + 16 * j] = f2bf(acc[i][j]); }
    }
};

__global__ __launch_bounds__(256) void k_attn(const bf16* Q, const bf16* Kb, const bf16* Vb, bf16* amix, const float* lq1, const float* lk1, const float* lq2, const float* lk2, const float* gsub) {
    extern __shared__ float sm[];
    float* s0 = sm; float* s1 = sm + KV; float* qs = sm + 2 * KV; float* red = qs + 128; float* osh = red + 8;
    const int row = blockIdx.x, h = blockIdx.y, b = row / S, t = threadIdx.x;
    if (t < 128) qs[t] = bf2f(Q[(size_t)row * 512 + h * 128 + t]);
    __syncthreads();
    float m0 = -1e30f, m1 = -1e30f;
    for (int key = t; key < KV; key += 256) { const bf16* kr = Kb + ((size_t)b * KV + key) * 512 + h * 128; float d0 = 0.f, d1 = 0.f;
        for (int d = 0; d < 64; ++d) { d0 += qs[d] * bf2f(kr[d]); d1 += qs[64 + d] * bf2f(kr[64 + d]); }
        s0[key] = d0; s1[key] = d1; m0 = fmaxf(m0, d0); m1 = fmaxf(m1, d1); }
    m0 = block_max(m0, red); m1 = block_max(m1, red);
    float l0 = 0.f, l1 = 0.f;
    for (int key = t; key < KV; key += 256) { const float p0 = exp2f(s0[key] - m0), p1 = exp2f(s1[key] - m1); s0[key] = p0; s1[key] = p1; l0 += p0; l1 += p1; }
    l0 = block_sum(l0, red); l1 = block_sum(l1, red);
    float a1 = 0.f, a2 = 0.f; for (int d = 0; d < 64; ++d) { a1 += lq1[d] * lk1[d]; a2 += lq2[d] * lk2[d]; }
    const float lam = expf(a1) - expf(a2) + 0.2f;
    const float i0 = 1.f / l0, i1 = lam / l1;
    for (int key = t; key < KV; key += 256) s0[key] = s0[key] * i0 - s1[key] * i1;
    __syncthreads();
    const int dv = t & 127, half = t >> 7; float o = 0.f;
    for (int key = half * (KV / 2); key < (half + 1) * (KV / 2); ++key) o += s0[key] * bf2f(Vb[((size_t)b * KV + key) * 512 + h * 128 + dv]);
    osh[t] = o; __syncthreads();
    o = osh[dv] + osh[128 + dv];
    const float ms = block_sum(t < 128 ? o * o : 0.f, red) / 128.f;
    if (t < 128) amix[(size_t)row * KO + h * 128 + dv] = f2bf(o * rsqrtf(ms + EPS) * gsub[dv] * 0.8f);
}
__global__ __launch_bounds__(256) void k_fft(const bf16* F, bf16* amix) {
    extern __shared__ float sm[];
    float2* tab = (float2*)sm; bf16* xs = (bf16*)(sm + 2 * 8192);
    const int u = blockIdx.y, t = threadIdx.x;
    for (int j = t; j < 8192; j += 256) { float sn, cs; sincospif((float)j / 4096.f, &sn, &cs); tab[j] = make_float2(cs, sn); }
    const bf16* xg = F + (size_t)u * S * 4;
    for (int j = t; j < S * 4 / 8; j += 256) ((uint4*)xs)[j] = ((const uint4*)xg)[j];
    __syncthreads();
    const int c = t & 3, k = blockIdx.x * 64 + (t >> 2);
    float re = 0.f, im = 0.f;
    for (int n = 0; n < S; ++n) { const float2 w = tab[(n * k) & 8191]; const float xv = bf2f(xs[n * 4 + c]); re += xv * w.x; im -= xv * w.y; }
    const int b = u >> 7, g = (u >> 5) & 3, cq = u & 31;
    bf16* dst = amix + ((size_t)b * S + k) * KO + 512 + g * 256 + 2 * (cq * 4 + c);
    dst[0] = f2bf(re); dst[1] = f2bf(im);
}
__global__ __launch_bounds__(256) void k_router(const float* xl, const float* gffn, const float* modv, const float* wrg, const float* brg, const float* wre, const float* bre,
                                                bf16* h2, unsigned* cnt, int* tokof, int* expid, int* posb, float* gate, const float* ssq16) {
    __shared__ float red[8]; __shared__ float hs[D]; __shared__ float lg[36];
    const int row = blockIdx.x, t = threadIdx.x, b = row / S;
    float v[4], ss = 0.f;
    for (int j = 0; j < 4; ++j) { v[j] = xl[(size_t)row * D + t + 256 * j]; ss += v[j] * v[j]; }
    float tot = block_sum(ss, red);
    if (ssq16) { tot = 0.f; for (int j = 0; j < 16; ++j) tot += ssq16[(size_t)row * 16 + j]; }
    const float rs = rsqrtf(tot / D + EPS);
    const float* mv = modv + b * 6144;
    for (int j = 0; j < 4; ++j) { const int k = t + 256 * j; const float hv = (v[j] * rs * gffn[k]) * (1.f + mv[4096 + k]) + mv[3072 + k]; hs[k] = hv; h2[(size_t)row * D + k] = f2bf(hv); }
    __syncthreads();
    const int w = t >> 6, lane = t & 63;
    for (int o = w; o < 36; o += 4) { float a = 0.f;
        for (int k = lane; k < D; k += 64) a += hs[k] * (o < 4 ? wrg[k * 4 + o] : wre[k * 32 + (o - 4)]);
        for (int s = 1; s < 64; s <<= 1) a += __shfl_xor(a, s);
        if (lane == 0) lg[o] = a + (o < 4 ? brg[o] : bre[o - 4]); }
    __syncthreads();
    if (t == 0) {
        int grp = 0; for (int i = 1; i < 4; ++i) if (lg[i] > lg[grp]) grp = i;
        float se = 0.f; for (int i = 0; i < 4; ++i) se += expf(lg[i] - lg[grp]);
        const float pg = 1.f / se;
        const float* el = lg + 4 + grp * 8;
        int i0 = 0; for (int i = 1; i < 8; ++i) if (el[i] > el[i0]) i0 = i;
        int i1 = (i0 == 0) ? 1 : 0; for (int i = 0; i < 8; ++i) if (i != i0 && el[i] > el[i1]) i1 = i;
        const float e1 = expf(el[i1] - el[i0]), g0 = pg / (1.f + e1), g1 = pg * e1 / (1.f + e1);
        const int ex[2] = {grp * 8 + i0, grp * 8 + i1}; const float gg[2] = {g0, g1};
        for (int k = 0; k < 2; ++k) { const int pos = (int)atomicAdd(&cnt[ex[k] * 64], 1u); tokof[ex[k] * 16384 + pos] = row;
            expid[row * 2 + k] = ex[k]; posb[row * 2 + k] = pos; gate[row * 2 + k] = gg[k]; }
    }
}
__global__ __launch_bounds__(256) void k_final(const float* xl, const bf16* ybuf, const unsigned* cnt, const int* expid, const int* posb, const float* gate, const float* modv, const float* gfin, float* out) {
    __shared__ float red[8]; __shared__ int sl[2];
    const int row = blockIdx.x, t = threadIdx.x, b = row / S;
    if (t < 2) sl[t] = slot_base(cnt, expid[row * 2 + t]) + posb[row * 2 + t];
    __syncthreads();
    const bf16* y0 = ybuf + (size_t)sl[0] * D; const bf16* y1 = ybuf + (size_t)sl[1] * D;
    float v[4], ss = 0.f;
    for (int j = 0; j < 4; ++j) { const int k = t + 256 * j; v[j] = xl[(size_t)row * D + k] + modv[b * 6144 + 5120 + k] * (gate[row * 2] * bf2f(y0[k]) + gate[row * 2 + 1] * bf2f(y1[k])); ss += v[j] * v[j]; }
    const float rs = rsqrtf(block_sum(ss, red) / D + EPS);
    for (int j = 0; j < 4; ++j) { const int k = t + 256 * j; out[(size_t)row * D + k] = v[j] * rs * gfin[k]; }
}

namespace pg8 {
#define PG8_LAS __attribute__((address_space(3)))
typedef unsigned short bf16_t;
typedef short bf16x8 __attribute__((ext_vector_type(8)));
typedef float f32x4 __attribute__((ext_vector_type(4)));
typedef unsigned u32x4 __attribute__((ext_vector_type(4)));
constexpr int BM = 256, BK = 64, HALF = 128, HTB = HALF * BK * 2  , STAGE_BYTES = 8 * HTB, NXCD = 8, WGM = 8;

__host__ __device__ __forceinline__ int lds_byte(int r, int c) { const int st = (r >> 4) * 2 + (c >> 5), rr = r & 15, cc = c & 31, ob = rr * 64 + cc * 2; return st * 1024 + (ob ^ (((ob >> 9) & 1) << 5)); }
__host__ __device__ __forceinline__ void stage_rc(int b, int& R, int& C) { const int st = b / 1024, sb = b % 1024, swz = sb ^ (((sb >> 9) & 1) << 5); R = (st >> 1) * 16 + swz / 64; C = (st & 1) * 32 + (swz % 64) / 2; }
__host__ __device__ __forceinline__ int perm32(int rho) { const int n = rho >> 4, i = rho & 15; return 8 * (i >> 2) + 4 * n + (i & 3); }

struct Unit { int pm, pn; };
struct Gemm { const bf16_t* A; const bf16_t* Bt; int M, N, K; };

struct StaticOrder {
    int nM, nN, nwg, G, c;
    __host__ __device__ void init(int M, int N, int G_, int c_) { nM = M / BM; nN = N / BM; nwg = nM * nN; G = G_; c = c_; }
    __host__ __device__ bool next(int i, Unit& u) const {
        const long L = (long)i * G + c; if (L >= nwg) return false;
        int wgid = (int)L; { const int q = nwg / NXCD, r = nwg % NXCD, xcd = wgid % NXCD, off = wgid / NXCD; wgid = (xcd < r ? xcd * (q + 1) : r * (q + 1) + (xcd - r) * q) + off; }
        const int nig = WGM * nN, gid = wgid / nig, fm = gid * WGM, gsz = (nM - fm) < WGM ? (nM - fm) : WGM;
        u.pm = fm + ((wgid % nig) % gsz); u.pn = (wgid % nig) / gsz; return true;
    }
    __device__ __forceinline__ void a_ready(const Unit&) const {}
    __device__ __forceinline__ void done(const Unit&) const {}
};

__device__ __forceinline__ unsigned cvt_pk_bf16(float lo, float hi) { typedef float f32x2_t __attribute__((ext_vector_type(2))); typedef __bf16 bf16x2_t __attribute__((ext_vector_type(2))); const f32x2_t v = {lo, hi}; return __builtin_bit_cast(unsigned, __builtin_convertvector(v, bf16x2_t)); }
typedef unsigned u32x2 __attribute__((ext_vector_type(2)));
__device__ __forceinline__ u32x2 pack4(f32x4 v) { u32x2 w; w.x = cvt_pk_bf16(v[0], v[1]); w.y = cvt_pk_bf16(v[2], v[3]); return w; }
struct EpiInProj {
    static constexpr bool PERM = false, AFTER_DRAIN = false;
    bf16_t *Q, *Kb, *Vb, *F; const float* rope;
    __device__ __forceinline__ void operator()(const f32x4 (&acc)[2][2][4][2], const Unit& u, int wr, int wc, int fr, int fq) const {
        const int sec = u.pn >> 1, colh = (u.pn & 1) * 256 + wc * 32 + 4 * fq;
#pragma unroll
        for (int ai = 0; ai < 2; ++ai)
#pragma unroll
            for (int m = 0; m < 4; ++m) {
                const int row = u.pm * BM + ai * HALF + wr * 64 + m * 16 + fr, b = row >> 13, s = row & 8191;
                if (sec < 2) {
                    const int pos = (wc & 1) ? (s & 63) : (s >> 6);
                    const f32x4 cs = *(const f32x4*)(rope + pos * 16 + 4 * fq), sn = *(const f32x4*)(rope + 2048 + pos * 16 + 4 * fq);
                    bf16_t* dst = sec == 0 ? Q + (size_t)row * 512 + colh : Kb + ((size_t)b * 8448 + 256 + s) * 512 + colh;
                    const float sc = sec == 0 ? 0.125f * 1.4426950408889634f : 1.f;
#pragma unroll
                    for (int bj = 0; bj < 2; ++bj) { const f32x4 x1 = acc[ai][bj][m][0], x2 = acc[ai][bj][m][1];
                        *(u32x2*)(dst + bj * HALF) = pack4((x1 * cs - x2 * sn) * sc); *(u32x2*)(dst + bj * HALF + 16) = pack4((x2 * cs + x1 * sn) * sc); }
                } else if (sec == 2) {
                    bf16_t* dst = Vb + ((size_t)b * 8448 + 256 + s) * 512 + colh;
#pragma unroll
                    for (int bj = 0; bj < 2; ++bj) { *(u32x2*)(dst + bj * HALF) = pack4(acc[ai][bj][m][0]); *(u32x2*)(dst + bj * HALF + 16) = pack4(acc[ai][bj][m][1]); }
                } else {
#pragma unroll
                    for (int bj = 0; bj < 2; ++bj)
#pragma unroll
                        for (int n = 0; n < 2; ++n) { const int g = (u.pn & 1) * 2 + bj, cq = 8 * wc + 4 * n + fq;
                            *(u32x2*)(F + ((((size_t)b * 4 + g) * 32 + cq) * 8192 + s) * 4) = pack4(acc[ai][bj][m][n]); }
                }
            }
    }
};
struct EpiOut {
    static constexpr bool PERM = false, AFTER_DRAIN = false;
    const float* x; const float* modv; float* xl; float* ssq;
    __device__ __forceinline__ void operator()(const f32x4 (&acc)[2][2][4][2], const Unit& u, int wr, int wc, int fr, int fq) const {
        const int col0 = u.pn * BM + wc * 32 + 4 * fq;
#pragma unroll
        for (int ai = 0; ai < 2; ++ai)
#pragma unroll
            for (int m = 0; m < 4; ++m) {
                const int row = u.pm * BM + ai * HALF + wr * 64 + m * 16 + fr, b = row >> 13; const size_t off = (size_t)row * 1024 + col0; const float* gt = modv + b * 6144 + 2048 + col0;
                float ss = 0.f;
#pragma unroll
                for (int bj = 0; bj < 2; ++bj)
#pragma unroll
                    for (int n = 0; n < 2; ++n) { const f32x4 xv = *(const f32x4*)(x + off + bj * HALF + n * 16), gv = *(const f32x4*)(gt + bj * HALF + n * 16);
                        const f32x4 o = xv + gv * acc[ai][bj][m][n]; *(f32x4*)(xl + off + bj * HALF + n * 16) = o; ss += (o[0] * o[0] + o[1] * o[1]) + (o[2] * o[2] + o[3] * o[3]); }
                ss += __shfl_xor(ss, 16); ss += __shfl_xor(ss, 32);
                if (fq == 0) ssq[(size_t)row * 16 + u.pn * 4 + wc] = ss;
                if (m & 1) asm volatile("" ::: "memory");
            }
    }
};
struct EpiGateUp {
    static constexpr bool PERM = false, AFTER_DRAIN = false;
    bf16_t* hmid;
    __device__ __forceinline__ void operator()(const f32x4 (&acc)[2][2][4][2], const Unit& u, int wr, int wc, int fr, int fq) const {
#pragma unroll
        for (int ai = 0; ai < 2; ++ai)
#pragma unroll
            for (int m = 0; m < 4; ++m) { const int slot = u.pm * BM + ai * HALF + wr * 64 + m * 16 + fr;
#pragma unroll
                for (int bj = 0; bj < 2; ++bj) { const f32x4 gv = acc[ai][bj][m][0], uv = acc[ai][bj][m][1]; f32x4 o;
#pragma unroll
                    for (int j = 0; j < 4; ++j) o[j] = gv[j] * __builtin_amdgcn_rcpf(1.f + __builtin_amdgcn_exp2f(-1.4426950408889634f * gv[j])) * uv[j];
                    *(u32x2*)(hmid + (size_t)slot * 512 + (8 * (u.pn & 3) + 4 * bj + wc) * 16 + 4 * fq) = pack4(o); } }
    }
};
struct EpiDown {
    static constexpr bool PERM = true, AFTER_DRAIN = false;
    bf16_t* ybuf;
    __device__ __forceinline__ void operator()(const f32x4 (&acc)[2][2][4][2], const Unit& u, int wr, int wc, int fr, int fq) const {
        const int col0 = (u.pn & 3) * BM + wc * 32 + 8 * fq;
#pragma unroll
        for (int ai = 0; ai < 2; ++ai)
#pragma unroll
            for (int m = 0; m < 4; ++m) { bf16_t* rowp = ybuf + (size_t)(u.pm * BM + ai * HALF + wr * 64 + m * 16 + fr) * 1024 + col0;
#pragma unroll
                for (int bj = 0; bj < 2; ++bj) { const f32x4 v0 = acc[ai][bj][m][0], v1 = acc[ai][bj][m][1]; u32x4 w; w.x = cvt_pk_bf16(v0[0], v0[1]); w.y = cvt_pk_bf16(v0[2], v0[3]); w.z = cvt_pk_bf16(v1[0], v1[1]); w.w = cvt_pk_bf16(v1[2], v1[3]);
                    *(u32x4*)(rowp + bj * HALF) = w; } }
    }
};
struct MoeOrder {
    int nunits, G, c; const PG8_LAS int* tb; const PG8_LAS int* toks;
    __device__ __forceinline__ bool next(int i, Unit& u) const {
        const int L = i * G + c; if (L >= nunits) return false;
        const int tile = L >> 2; int e = 0;
        for (int j = 1; j < 32; ++j) e += (tb[j] <= tile) ? 1 : 0;
        u.pm = tile; u.pn = e * 4 + (L & 3); return true;
    }
    __device__ __forceinline__ int arow(int i, int r) const { return toks[i * 256 + r]; }
    __device__ __forceinline__ void a_ready(const Unit&) const {}
    __device__ __forceinline__ void done(const Unit&) const {}
};
template <class Epi, class Sched, bool ALIGN_EPI = false, bool SP2 = false, bool GATHER = false>
__device__ __forceinline__ void gemm_phase(PG8_LAS unsigned char* lds, const Gemm g, const Sched& S, const Epi& E) {
    const int tid = threadIdx.x, wid = __builtin_amdgcn_readfirstlane(tid >> 6), lane = tid & 63, wr = wid >> 2, wc = wid & 3, fr = lane & 15, fq = lane >> 4;
    const int K = g.K, nt = K / BK;
    unsigned voffA[2], voffB[2]; int gR0 = 0; unsigned gC0 = 0u;
    unsigned vA[2][2];
#pragma unroll
    for (int i = 0; i < 2; ++i) { int R, C; stage_rc(tid * 16 + i * 8192, R, C); const int Rb = Epi::PERM ? ((R & ~31) + perm32(R & 31)) : R;
        voffA[i] = (unsigned)(R * K + C) * 2u; voffB[i] = (unsigned)(Rb * K + C) * 2u; if (i == 0) { gR0 = R; gC0 = (unsigned)C * 2u; } }
    const size_t kstep = (size_t)(BK * 2);
    const size_t hstep = (size_t)HALF * K * 2;
    const size_t tstep = 2 * hstep;
    const unsigned ldsw = (unsigned)wid * 1024u;
    const int aoff = lds_byte(wr * 64 + fr, fq * 8), boff = lds_byte(wc * 32 + fr, fq * 8);
#define PG8_SA(b, h) (((b) * 2 + (h)) * HTB)
#define PG8_SB(b, h) ((4 + (b) * 2 + (h)) * HTB)
#define PG8_STAGE(bufoff, gbase, voff) do { _Pragma("unroll") for (int _i = 0; _i < 2; ++_i) \
        __builtin_amdgcn_global_load_lds((const unsigned*)((const char*)(gbase) + (voff)[_i]), (PG8_LAS unsigned*)(lds + (bufoff) + ldsw + _i * 8192), 16, 0, 0); } while (0)
#define PG8_STAGE_A(bufoff, gbase, h, nx) do { if constexpr (GATHER) { PG8_STAGE(bufoff, gbase, vA[h]); } else { PG8_STAGE(bufoff, (gbase) + (h) * hstep, voffA); } } while (0)
#define PG8_GATHER_OFFS(dst, uidx) do { _Pragma("unroll") for (int _h = 0; _h < 2; ++_h) _Pragma("unroll") for (int _i = 0; _i < 2; ++_i) dst[_h][_i] = (unsigned)S.arow(uidx, _h * HALF + gR0 + 64 * _i) * (unsigned)(K * 2) + gC0; } while (0)
#define PG8_LDA(dst, b, h) do { _Pragma("unroll") for (int m = 0; m < 4; ++m) _Pragma("unroll") for (int k = 0; k < 2; ++k) dst[m][k] = *(const PG8_LAS bf16x8*)(lds + PG8_SA(b, h) + aoff + m * 2048 + k * 1024); } while (0)
#define PG8_LDB(dst, b, h) do { _Pragma("unroll") for (int n = 0; n < 2; ++n) _Pragma("unroll") for (int k = 0; k < 2; ++k) dst[n][k] = *(const PG8_LAS bf16x8*)(lds + PG8_SB(b, h) + boff + n * 2048 + k * 1024); } while (0)
#define PG8_MMA(ai, bj, At, Bt) do { __builtin_amdgcn_s_setprio(1); _Pragma("unroll") for (int m = 0; m < 4; ++m) _Pragma("unroll") for (int n = 0; n < 2; ++n) _Pragma("unroll") for (int k = 0; k < 2; ++k) \
        acc[ai][bj][m][n] = __builtin_amdgcn_mfma_f32_16x16x32_bf16(Bt[n][k], At[m][k], acc[ai][bj][m][n], 0, 0, 0); __builtin_amdgcn_s_setprio(0); } while (0)
#define PG8_WAIT_V(n) asm volatile("s_waitcnt vmcnt(" #n ")" ::: "memory")
#define PG8_WAIT_L(n) asm volatile("s_waitcnt lgkmcnt(" #n ")" ::: "memory")
#define PG8_BAR __builtin_amdgcn_s_barrier()
#define PG8_SCHED __builtin_amdgcn_sched_barrier(0)
    Unit cur, nxt; int ui = 0;
    if (!S.next(0, cur)) return;
    f32x4 acc[2][2][4][2];
#pragma unroll
    for (int a = 0; a < 2; ++a)
#pragma unroll
        for (int b = 0; b < 2; ++b)
#pragma unroll
            for (int m = 0; m < 4; ++m)
#pragma unroll
                for (int n = 0; n < 2; ++n) acc[a][b][m][n] = (f32x4){0.f, 0.f, 0.f, 0.f};
    bf16x8 At[4][2], B0[2][2], B1[2][2];
    const char* cA = GATHER ? (const char*)g.A : (const char*)g.A + (size_t)cur.pm * tstep; const char* cB = (const char*)g.Bt + (size_t)cur.pn * tstep;
    if constexpr (GATHER) { PG8_GATHER_OFFS(vA, 0); }
    S.a_ready(cur);
    if constexpr (SP2) {
        PG8_STAGE(PG8_SB(0, 0), cB, voffB); PG8_STAGE(PG8_SB(0, 1), cB + hstep, voffB); PG8_STAGE_A(PG8_SA(0, 0), cA, 0, false); PG8_STAGE_A(PG8_SA(0, 1), cA, 1, false);
        if (wr == 1) PG8_BAR;
        PG8_WAIT_V(2); PG8_BAR;
        PG8_STAGE(PG8_SB(1, 0), cB + kstep, voffB); PG8_STAGE_A(PG8_SA(1, 0), cA + kstep, 0, false); PG8_STAGE(PG8_SB(1, 1), cB + hstep + kstep, voffB);
        PG8_WAIT_V(6); PG8_BAR;
    } else {
        PG8_STAGE(PG8_SB(0, 0), cB, voffB); PG8_STAGE_A(PG8_SA(0, 0), cA, 0, false); PG8_STAGE(PG8_SB(0, 1), cB + hstep, voffB); PG8_STAGE_A(PG8_SA(0, 1), cA, 1, false);
        if (wr == 1) PG8_BAR;
        PG8_WAIT_V(4); PG8_BAR;
        PG8_STAGE(PG8_SB(1, 0), cB + kstep, voffB); PG8_STAGE_A(PG8_SA(1, 0), cA + kstep, 0, false); PG8_STAGE(PG8_SB(1, 1), cB + hstep + kstep, voffB);
        PG8_WAIT_V(6); PG8_BAR;
    }
    for (;;) {
        const bool has_next = S.next(ui + 1, nxt);
        const char* nA = GATHER ? cA : (has_next ? (const char*)g.A + (size_t)nxt.pm * tstep : cA); const char* nB = has_next ? (const char*)g.Bt + (size_t)nxt.pn * tstep : cB;

        for (int t = 0; t < nt; t += 2) {
            const bool last = (t == nt - 2);
            const char* a1 = cA + (size_t)(t + 1) * kstep;
            const char* a2 = last ? nA : cA + (size_t)(t + 2) * kstep; const char* b2 = last ? nB : cB + (size_t)(t + 2) * kstep;
            const char* a3 = a2 + kstep; const char* b3 = b2 + kstep;
            if (last && has_next) S.a_ready(nxt);
            if constexpr (SP2) {
            PG8_LDB(B0, 0, 0); PG8_LDB(B1, 0, 1); PG8_SCHED; PG8_LDA(At, 0, 0); PG8_STAGE_A(PG8_SA(1, 1), a1, 1, false);
            if constexpr (GATHER) { if (last && has_next) { PG8_GATHER_OFFS(vA, ui + 1); } }
            PG8_WAIT_V(8); PG8_WAIT_L(0); PG8_BAR; PG8_MMA(0, 0, At, B0); PG8_MMA(0, 1, At, B1); PG8_BAR; PG8_SCHED;
            PG8_LDA(At, 0, 1); PG8_STAGE(PG8_SB(0, 0), b2, voffB); PG8_STAGE(PG8_SB(0, 1), b2 + hstep, voffB); PG8_STAGE_A(PG8_SA(0, 0), a2, 0, last);
            PG8_WAIT_V(8); PG8_WAIT_L(0); PG8_BAR; PG8_MMA(1, 0, At, B0); PG8_MMA(1, 1, At, B1); PG8_BAR; PG8_SCHED;
            PG8_LDB(B0, 1, 0); PG8_LDB(B1, 1, 1); PG8_SCHED; PG8_LDA(At, 1, 0); PG8_STAGE_A(PG8_SA(0, 1), a2, 1, last);
            PG8_WAIT_V(8); PG8_WAIT_L(0); PG8_BAR; PG8_MMA(0, 0, At, B0); PG8_MMA(0, 1, At, B1); PG8_BAR; PG8_SCHED;
            PG8_LDA(At, 1, 1); PG8_STAGE(PG8_SB(1, 0), b3, voffB); PG8_STAGE(PG8_SB(1, 1), b3 + hstep, voffB); PG8_STAGE_A(PG8_SA(1, 0), a3, 0, last);
            PG8_WAIT_V(8); PG8_WAIT_L(0); PG8_BAR; PG8_MMA(1, 0, At, B0); PG8_MMA(1, 1, At, B1); PG8_BAR; PG8_SCHED;
            } else {
            PG8_LDB(B0, 0, 0); PG8_SCHED; PG8_LDA(At, 0, 0); PG8_STAGE_A(PG8_SA(1, 1), a1, 1, false);
            if constexpr (GATHER) { if (last && has_next) { PG8_GATHER_OFFS(vA, ui + 1); } }
            PG8_WAIT_L(8); PG8_BAR; PG8_WAIT_L(0); PG8_MMA(0, 0, At, B0); PG8_BAR; PG8_SCHED;
            PG8_LDB(B1, 0, 1); PG8_STAGE(PG8_SB(0, 0), b2, voffB);
            PG8_BAR; PG8_WAIT_L(0); PG8_MMA(0, 1, At, B1); PG8_BAR;
            PG8_LDA(At, 0, 1); PG8_STAGE_A(PG8_SA(0, 0), a2, 0, last);
            PG8_BAR; PG8_WAIT_L(0); PG8_MMA(1, 0, At, B0); PG8_BAR; PG8_SCHED;
            PG8_STAGE(PG8_SB(0, 1), b2 + hstep, voffB);
            PG8_WAIT_V(6); PG8_BAR; PG8_MMA(1, 1, At, B1); PG8_BAR;
            PG8_LDB(B0, 1, 0); PG8_SCHED; PG8_LDA(At, 1, 0); PG8_STAGE_A(PG8_SA(0, 1), a2, 1, last);
            PG8_WAIT_L(8); PG8_BAR; PG8_WAIT_L(0); PG8_MMA(0, 0, At, B0); PG8_BAR; PG8_SCHED;
            PG8_LDB(B1, 1, 1); PG8_STAGE(PG8_SB(1, 0), b3, voffB);
            PG8_BAR; PG8_WAIT_L(0); PG8_MMA(0, 1, At, B1); PG8_BAR;
            PG8_LDA(At, 1, 1); PG8_STAGE_A(PG8_SA(1, 0), a3, 0, last);
            PG8_BAR; PG8_WAIT_L(0); PG8_MMA(1, 0, At, B0); PG8_BAR; PG8_SCHED;
            PG8_STAGE(PG8_SB(1, 1), b3 + hstep, voffB);
            PG8_WAIT_V(6); PG8_BAR; PG8_MMA(1, 1, At, B1); PG8_BAR;
            }
        }
        if constexpr (ALIGN_EPI) { if (wr == 0) PG8_BAR; }
        if constexpr (!Epi::AFTER_DRAIN) { E(acc, cur, wr, wc, fr, fq); S.done(cur); }
        if (!has_next) break;
#pragma unroll
        for (int a = 0; a < 2; ++a)
#pragma unroll
            for (int b = 0; b < 2; ++b)
#pragma unroll
                for (int m = 0; m < 4; ++m)
#pragma unroll
                    for (int n = 0; n < 2; ++n) acc[a][b][m][n] = (f32x4){0.f, 0.f, 0.f, 0.f};
        cur = nxt; cA = nA; cB = nB; ++ui;
        if constexpr (ALIGN_EPI) { if (wr == 1) PG8_BAR; }
    }
    PG8_WAIT_V(0);
    if constexpr (!ALIGN_EPI) { if (wr == 0) PG8_BAR; }
    PG8_BAR;
    if constexpr (Epi::AFTER_DRAIN) { E.fused(acc, cur, wr, wc, fr, fq, lds, wid, lane); S.done(cur); }
#undef PG8_SA
#undef PG8_SB
#undef PG8_STAGE
#undef PG8_STAGE_A
#undef PG8_GATHER_OFFS
#undef PG8_LDA
#undef PG8_LDB
#undef PG8_MMA
#undef PG8_WAIT_V
#undef PG8_WAIT_L
#undef PG8_BAR
#undef PG8_SCHED
}
}

#define GAS __attribute__((address_space(1)))
#define LAS __attribute__((address_space(3)))
typedef GAS unsigned gu32;
#define RLX_AGENT __ATOMIC_RELAXED, __HIP_MEMORY_SCOPE_AGENT
#define LDS_WAIT() asm volatile("s_waitcnt lgkmcnt(0)" ::: "memory")
#define VM_WAIT() asm volatile("s_waitcnt vmcnt(0)" ::: "memory")

#define XB_TMO      128
#define XB_XCNT(j)  (256  + 64 * (j))
#define XB_XSUB(j)  (1280 + 64 * (j))
#define XB_XGEN(j)  (2304 + 64 * (j))
#define XB_TOP      3328
#define XB_TOPGEN   3392
#define XCD_BAR_WORDS 3456
#define XB_SPIN_CAP (1u << 18)

__device__ __forceinline__ unsigned xb_ld(unsigned* p)              { return __hip_atomic_load(p, __ATOMIC_RELAXED, __HIP_MEMORY_SCOPE_AGENT); }
__device__ __forceinline__ unsigned xb_add(unsigned* p, unsigned v) { return __hip_atomic_fetch_add(p, v, __ATOMIC_RELAXED, __HIP_MEMORY_SCOPE_AGENT); }
__device__ __forceinline__ unsigned xb_xcc_id() { return (unsigned)__builtin_amdgcn_s_getreg((3 << 11) | 20) & 0xFu; }
#define XB_SPIN(cond, bar) do { unsigned _sp = 0; while (cond) { __builtin_amdgcn_s_sleep(1); \
    if ((++_sp & 255u) == 0u) { if (xb_ld(&(bar)[XB_TMO])) break; if (_sp > XB_SPIN_CAP) { atomicAdd(&(bar)[XB_TMO], 1u); break; } } } } while (0)

struct XcdBarrier {
    unsigned* bar; unsigned x;
    volatile LAS unsigned* st;
};

__device__ __forceinline__ XcdBarrier xcd_barrier_post(unsigned* bar, volatile LAS unsigned* st) {
    XcdBarrier b; b.bar = bar; b.x = xb_xcc_id(); b.st = st;
    if (threadIdx.x == 0) (void)xb_add(&bar[XB_XCNT(b.x)], 1u);
    return b;
}
__device__ __forceinline__ void xcd_barrier_complete(unsigned* bar, unsigned x, unsigned& nloc, unsigned& nx) {
    const unsigned G = gridDim.x * gridDim.y * gridDim.z;
    unsigned sum, cnt, mine, sp = 0u;
    for (;;) {
        sum = 0u; cnt = 0u; mine = 0u;
#pragma unroll
        for (unsigned j = 0; j < 16; ++j) { const unsigned c = xb_ld(&bar[XB_XCNT(j)]); sum += c; cnt += (c > 0u) ? 1u : 0u; mine = (j == x) ? c : mine; }
        if (sum == G) break;
        __builtin_amdgcn_s_sleep(1);
        if ((++sp & 255u) == 0u) { if (xb_ld(&bar[XB_TMO])) break; if (sp > XB_SPIN_CAP) { atomicAdd(&bar[XB_TMO], 1u); break; } }
    }
    nloc = mine > 0u ? mine : 1u; nx = cnt > 0u ? cnt : 1u;
}

__device__ __forceinline__ void xcd_barrier(const XcdBarrier& b) {
    asm volatile("s_waitcnt vmcnt(0)" ::: "memory");
    __syncthreads();
    if (threadIdx.x == 0) {
        unsigned* bar = b.bar;
        __builtin_amdgcn_s_waitcnt(0);
        unsigned nloc = b.st[0], nx = b.st[1];
        if (nloc == 0u) { xcd_barrier_complete(bar, b.x, nloc, nx); b.st[0] = nloc; b.st[1] = nx; }
        const unsigned old = xb_add(&bar[XB_XSUB(b.x)], 1u);
        const unsigned gen = old / nloc;
        if (old + 1u == (gen + 1u) * nloc) {
            __builtin_amdgcn_fence(__ATOMIC_RELEASE, "agent");
            asm volatile("s_waitcnt vmcnt(0)" ::: "memory");
            const unsigned og = xb_add(&bar[XB_TOP], 1u);
            const unsigned tg = og / nx;
            if (og + 1u == (tg + 1u) * nx) xb_add(&bar[XB_TOPGEN], 1u);
            else XB_SPIN(xb_ld(&bar[XB_TOPGEN]) == tg, bar);
            __builtin_amdgcn_fence(__ATOMIC_ACQUIRE, "agent");
            xb_add(&bar[XB_XGEN(b.x)], 1u);
            asm volatile("s_waitcnt vmcnt(0)" ::: "memory");
        } else {
            XB_SPIN(xb_ld(&bar[XB_XGEN(b.x)]) == gen, bar);
            __builtin_amdgcn_fence(__ATOMIC_ACQUIRE, "agent");
            asm volatile("s_waitcnt vmcnt(0)" ::: "memory");
        }
    }
    __syncthreads();
}

namespace da {
using bf16x8 = __attribute__((ext_vector_type(8))) short;
using s16x4  = __attribute__((ext_vector_type(4))) short;
using f32x16 = __attribute__((ext_vector_type(16))) float;
using u32x4  = __attribute__((ext_vector_type(4))) unsigned;
constexpr int NW = 8, QBLK = 32, KVBLK = 64, LDK = 512;
constexpr int NSLOT = 3, SHM_V = KVBLK * 128 * 2, SHM_K = KVBLK * 128 * 2, SHM_ATTN = NSLOT * (SHM_V + SHM_K) + NW * 64 * 4;
constexpr float THRL = 8.f;
#define DA_KSWZ(row, colB) ((row) * 256 + ((colB) ^ (((row) & 7) << 4)))
#define DA_SBAR() __builtin_amdgcn_sched_barrier(0)
__device__ __forceinline__ int crow(int r, int hi) { return (r & 3) + 8 * (r >> 2) + 4 * hi; }
__device__ __forceinline__ unsigned cvtpk(float lo, float hi) { typedef float f32x2_t __attribute__((ext_vector_type(2))); typedef __bf16 bf16x2_t __attribute__((ext_vector_type(2))); const f32x2_t v = {lo, hi}; return __builtin_bit_cast(unsigned, __builtin_convertvector(v, bf16x2_t)); }
__device__ __forceinline__ void partialSM(f32x16& p0, f32x16& p1, float& m_reg, float& mn, float& alpha) {
  float pmax = p0[0];
#pragma unroll
  for (int r = 1; r < 16; ++r) pmax = fmaxf(pmax, p0[r]);
#pragma unroll
  for (int r = 0; r < 16; ++r) pmax = fmaxf(pmax, p1[r]);
  { auto rr = __builtin_amdgcn_permlane32_swap(__float_as_uint(pmax), __float_as_uint(pmax), false, false);
    pmax = fmaxf(__uint_as_float(rr[0]), __uint_as_float(rr[1])); }
  if (__builtin_expect(__all(pmax - m_reg <= THRL), 1)) { mn = m_reg; alpha = 1.f; }
  else { mn = fmaxf(m_reg, pmax); alpha = __builtin_amdgcn_exp2f(m_reg - mn); m_reg = mn; }
#pragma unroll
  for (int r = 0; r < 16; ++r) p0[r] = p0[r] - mn;
#pragma unroll
  for (int r = 0; r < 16; ++r) p1[r] = p1[r] - mn;
#pragma unroll
  for (int r = 0; r < 16; ++r) p0[r] = __builtin_amdgcn_exp2f(p0[r]);
}
__device__ __forceinline__ void finishSM(f32x16& p0, f32x16& p1, float alpha, float& l_reg, bf16x8& pa0, bf16x8& pa1, bf16x8& pa2, bf16x8& pa3) {
#pragma unroll
  for (int r = 0; r < 16; ++r) p1[r] = __builtin_amdgcn_exp2f(p1[r]);
  float ps = 0;
#pragma unroll
  for (int r = 0; r < 16; ++r) ps += p0[r];
#pragma unroll
  for (int r = 0; r < 16; ++r) ps += p1[r];
  { auto rr = __builtin_amdgcn_permlane32_swap(__float_as_uint(ps), __float_as_uint(ps), false, false);
    ps = __uint_as_float(rr[0]) + __uint_as_float(rr[1]); }
  l_reg = l_reg * alpha + ps;
#define DA_PK4(P, BASE, OUT) do { unsigned a0 = cvtpk(P[BASE + 0], P[BASE + 1]), a1 = cvtpk(P[BASE + 2], P[BASE + 3]);   \
    unsigned b0 = cvtpk(P[BASE + 4], P[BASE + 5]), b1 = cvtpk(P[BASE + 6], P[BASE + 7]);                              \
    auto r0 = __builtin_amdgcn_permlane32_swap(a0, b0, false, false); auto r1 = __builtin_amdgcn_permlane32_swap(a1, b1, false, false); \
    u32x4 w = {r0[0], r1[0], r0[1], r1[1]}; OUT = __builtin_bit_cast(bf16x8, w); } while (0)
  DA_PK4(p0, 0, pa0); DA_PK4(p0, 8, pa1); DA_PK4(p1, 0, pa2); DA_PK4(p1, 8, pa3);
#undef DA_PK4
}
__device__ __forceinline__ void fakeSM(f32x16& p0, f32x16& p1, bf16x8& pa0, bf16x8& pa1, bf16x8& pa2, bf16x8& pa3) {
#define DA_PK4(P, BASE, OUT) do { unsigned a0 = cvtpk(P[BASE + 0], P[BASE + 1]), a1 = cvtpk(P[BASE + 2], P[BASE + 3]), b0 = cvtpk(P[BASE + 4], P[BASE + 5]), b1 = cvtpk(P[BASE + 6], P[BASE + 7]); \
    u32x4 w = {a0, a1, b0, b1}; OUT = __builtin_bit_cast(bf16x8, w); } while (0)
  DA_PK4(p0, 0, pa0); DA_PK4(p0, 8, pa1); DA_PK4(p1, 0, pa2); DA_PK4(p1, 8, pa3);
#undef DA_PK4
}
__device__ __forceinline__ void qkt(f32x16& p0, f32x16& p1, const LAS char* Ks, const bf16x8* qr, int r32, int hi, int mb) {
  p0 = f32x16{}; p1 = f32x16{};
#pragma unroll
  for (int d0 = 0; d0 < 4; ++d0) { const int cb = mb + (d0 * 16 + hi * 8) * 2;
    const bf16x8 b0 = *(const LAS bf16x8*)(Ks + DA_KSWZ(r32, cb));
    const bf16x8 b1 = *(const LAS bf16x8*)(Ks + DA_KSWZ(32 + r32, cb));
    p0 = __builtin_amdgcn_mfma_f32_32x32x16_bf16(b0, qr[d0], p0, 0, 0, 0);
    p1 = __builtin_amdgcn_mfma_f32_32x32x16_bf16(b1, qr[d0], p1, 0, 0, 0); }
}
__device__ __forceinline__ void glds16(const void* gsrc, unsigned lds_dst) { unsigned keep;
  asm volatile("s_mov_b32 %0, m0\n\ts_mov_b32 m0, %2\n\ts_nop 0\n\tglobal_load_lds_dwordx4 %1, off\n\ts_mov_b32 m0, %0" : "=&s"(keep) : "v"(gsrc), "s"(lds_dst) : "memory"); }
__device__ __forceinline__ void glds16s(const void* sbase, unsigned voff, unsigned lds_dst) { unsigned keep;
  asm volatile("s_mov_b32 %0, m0\n\ts_mov_b32 m0, %3\n\ts_nop 0\n\tglobal_load_lds_dwordx4 %1, %2\n\ts_mov_b32 m0, %0" : "=&s"(keep) : "v"(voff), "s"(sbase), "s"(lds_dst) : "memory"); }
__device__ __forceinline__ int v_st(int k, int c) { const int kk = (k & ~0xC) | ((k & 4) << 1) | ((k & 8) >> 1); return ((kk >> 3) * 4 + (c >> 5)) * 512 + ((kk & 7) * 32 + (c & 31)) * 2; }
__device__ __forceinline__ int v_rd_base(int lane) { return ((lane & 3) << 3) | (((lane >> 2) & 3) << 6) | (((lane >> 4) & 1) << 5) | (((lane >> 5) & 1) << 8); }
constexpr int v_rd_off(int d0, int ks, int half) { return d0 * 512 + ks * 4096 + half * 2048; }
template <int OFF> __device__ __forceinline__ s16x4 tr_read(int vb) { s16x4 r; asm volatile("ds_read_b64_tr_b16 %0, %1 offset:%2" : "=&v"(r) : "v"(vb), "i"(OFF) : "memory"); return r; }
template <int D0> __device__ __forceinline__ void pv_one(f32x16& od, int vb, bf16x8 pa0, bf16x8 pa1, bf16x8 pa2, bf16x8 pa3) {
  const s16x4 l0 = tr_read<v_rd_off(D0, 0, 0)>(vb), h0 = tr_read<v_rd_off(D0, 0, 1)>(vb), l1 = tr_read<v_rd_off(D0, 1, 0)>(vb), h1 = tr_read<v_rd_off(D0, 1, 1)>(vb);
  const s16x4 l2 = tr_read<v_rd_off(D0, 2, 0)>(vb), h2 = tr_read<v_rd_off(D0, 2, 1)>(vb), l3 = tr_read<v_rd_off(D0, 3, 0)>(vb), h3 = tr_read<v_rd_off(D0, 3, 1)>(vb);
  asm volatile("s_waitcnt lgkmcnt(0)" ::: "memory"); DA_SBAR();
#define DA_PK(L, H) (bf16x8){L[0], L[1], L[2], L[3], H[0], H[1], H[2], H[3]}
  od = __builtin_amdgcn_mfma_f32_32x32x16_bf16(pa0, DA_PK(l0, h0), od, 0, 0, 0);
  od = __builtin_amdgcn_mfma_f32_32x32x16_bf16(pa1, DA_PK(l1, h1), od, 0, 0, 0);
  od = __builtin_amdgcn_mfma_f32_32x32x16_bf16(pa2, DA_PK(l2, h2), od, 0, 0, 0);
  od = __builtin_amdgcn_mfma_f32_32x32x16_bf16(pa3, DA_PK(l3, h3), od, 0, 0, 0);
#undef DA_PK
}
__device__ __forceinline__ void pv_d0(f32x16* o, int vb, bf16x8 pa0, bf16x8 pa1, bf16x8 pa2, bf16x8 pa3) {
  pv_one<0>(o[0], vb, pa0, pa1, pa2, pa3); pv_one<1>(o[1], vb, pa0, pa1, pa2, pa3); pv_one<2>(o[2], vb, pa0, pa1, pa2, pa3); pv_one<3>(o[3], vb, pa0, pa1, pa2, pa3);
}
typedef short v4i16_t __attribute__((ext_vector_type(4)));
__device__ __forceinline__ s16x4 vtr(const LAS char* p) { return __builtin_bit_cast(s16x4, __builtin_amdgcn_ds_read_tr16_b64_v4i16((LAS v4i16_t*)p)); }
__device__ __forceinline__ void pv_psm(f32x16* o, int vb, bf16x8 pa0, bf16x8 pa1, bf16x8 pa2, bf16x8 pa3, f32x16& p0, f32x16& p1, float& m_reg, float& mn, float& alpha) {
#define DA_PK(L, H) (bf16x8){L[0], L[1], L[2], L[3], H[0], H[1], H[2], H[3]}
#define DA_RD8(D0) const s16x4 l0 = tr_read<v_rd_off(D0, 0, 0)>(vb), h0 = tr_read<v_rd_off(D0, 0, 1)>(vb), l1 = tr_read<v_rd_off(D0, 1, 0)>(vb), h1 = tr_read<v_rd_off(D0, 1, 1)>(vb), \
    l2 = tr_read<v_rd_off(D0, 2, 0)>(vb), h2 = tr_read<v_rd_off(D0, 2, 1)>(vb), l3 = tr_read<v_rd_off(D0, 3, 0)>(vb), h3 = tr_read<v_rd_off(D0, 3, 1)>(vb)
#define DA_MM4(D0) do { asm volatile("s_waitcnt lgkmcnt(0)" ::: "memory"); DA_SBAR(); \
    o[D0] = __builtin_amdgcn_mfma_f32_32x32x16_bf16(pa0, DA_PK(l0, h0), o[D0], 0, 0, 0); o[D0] = __builtin_amdgcn_mfma_f32_32x32x16_bf16(pa1, DA_PK(l1, h1), o[D0], 0, 0, 0); \
    o[D0] = __builtin_amdgcn_mfma_f32_32x32x16_bf16(pa2, DA_PK(l2, h2), o[D0], 0, 0, 0); o[D0] = __builtin_amdgcn_mfma_f32_32x32x16_bf16(pa3, DA_PK(l3, h3), o[D0], 0, 0, 0); } while (0)
  float pmax;
  { DA_RD8(0);
    pmax = p0[0];
#pragma unroll
    for (int r = 1; r < 16; ++r) pmax = fmaxf(pmax, p0[r]);
    DA_MM4(0); }
  { DA_RD8(1);
#pragma unroll
    for (int r = 0; r < 16; ++r) pmax = fmaxf(pmax, p1[r]);
    { auto rr = __builtin_amdgcn_permlane32_swap(__float_as_uint(pmax), __float_as_uint(pmax), false, false);
      pmax = fmaxf(__uint_as_float(rr[0]), __uint_as_float(rr[1])); }
    if (__builtin_expect(__all(pmax - m_reg <= THRL), 1)) { mn = m_reg; alpha = 1.f; }
    else { mn = fmaxf(m_reg, pmax); alpha = __builtin_amdgcn_exp2f(m_reg - mn); m_reg = mn; }
    DA_MM4(1); }
  { DA_RD8(2);
#pragma unroll
    for (int r = 0; r < 16; ++r) p0[r] = p0[r] - mn;
#pragma unroll
    for (int r = 0; r < 16; ++r) p1[r] = p1[r] - mn;
    DA_MM4(2); }
  { DA_RD8(3);
#pragma unroll
    for (int r = 0; r < 16; ++r) p0[r] = __builtin_amdgcn_exp2f(p0[r]);
    DA_MM4(3); }
#undef DA_PK
#undef DA_RD8
#undef DA_MM4
}
typedef float f32x4s __attribute__((ext_vector_type(4)));
struct SideCvt {
  const float* w_gate; const float* w_up; const float* w_down; bf16* wgu; bf16* wd; LAS float* scr;
  int item, item_end, stride, ph;
  const float* src; bf16* dst; int N, ldo, mode;
  f32x4s r0, r1;
};
__device__ __forceinline__ bool side_step(SideCvt& s, int lane) {
  if (s.item >= s.item_end) return false;
  const int rr = lane >> 3, c4 = (lane & 7) * 4;
  if (s.ph == 0) {
    const int e = s.item / 1536; int r = s.item - e * 1536; int kb, nb;
    if (r < 1024) { const bool up = r >= 512; r &= 511; kb = r >> 4; nb = r & 15; s.N = 512; s.ldo = 1024; s.mode = up ? 2 : 1;
      s.src = (up ? s.w_up : s.w_gate) + (size_t)e * (1024 * 512) + (size_t)(32 * kb) * 512 + 32 * nb; s.dst = s.wgu + (size_t)e * (1024 * 1024) + 32 * kb;
      s.dst += (size_t)(((32 * nb) >> 4) * 32 + (up ? 16 : 0)) * 1024; }
    else { r -= 1024; kb = r >> 5; nb = r & 31; s.N = 1024; s.ldo = 512; s.mode = 0;
      s.src = s.w_down + (size_t)e * (512 * 1024) + (size_t)(32 * kb) * 1024 + 32 * nb; s.dst = s.wd + (size_t)e * (1024 * 512) + (size_t)(32 * nb) * 512 + 32 * kb; }
    s.r0 = *(const f32x4s*)(s.src + (size_t)rr * s.N + c4); s.r1 = *(const f32x4s*)(s.src + (size_t)(rr + 8) * s.N + c4);
    s.ph = 1; return true;
  }
  if (s.ph == 1) {
    *(LAS f32x4s*)(s.scr + rr * 36 + c4) = s.r0; *(LAS f32x4s*)(s.scr + (rr + 8) * 36 + c4) = s.r1;
    s.r0 = *(const f32x4s*)(s.src + (size_t)(rr + 16) * s.N + c4); s.r1 = *(const f32x4s*)(s.src + (size_t)(rr + 24) * s.N + c4);
    s.ph = 2; return true;
  }
  *(LAS f32x4s*)(s.scr + (rr + 16) * 36 + c4) = s.r0; *(LAS f32x4s*)(s.scr + (rr + 24) * 36 + c4) = s.r1;
  asm volatile("s_waitcnt lgkmcnt(0)" ::: "memory");
#pragma unroll
  for (int h = 0; h < 2; ++h) { const int t = lane + 64 * h, nl = t >> 2, kc = (t & 3) * 8; const LAS float* p = s.scr + kc * 36 + nl;
    u32x4 o; o.x = cvtpk(p[0], p[36]); o.y = cvtpk(p[72], p[108]); o.z = cvtpk(p[144], p[180]); o.w = cvtpk(p[216], p[252]);
    const int row = s.mode == 0 ? nl : ((nl >> 4) * 32 + (nl & 15));
    *(u32x4*)(s.dst + (size_t)row * s.ldo + kc) = o; }
  s.item += s.stride; s.ph = 0; return true;
}
template <int VAR> __device__ __forceinline__ void attn_unit(const bf16* __restrict__ Qb, const bf16* __restrict__ Kh, const bf16* __restrict__ Vh, bf16* __restrict__ Ob, int ldo, int seq,
                                          LAS unsigned char* lds, unsigned lds0, float lam, const float (&gs)[4], SideCvt& side) {
  const int tid = threadIdx.x, wid = __builtin_amdgcn_readfirstlane(tid >> 6), lane = tid & 63, r32 = lane & 31, hi = lane >> 5, map = wid >> 2, rg = wid & 3, mb = map * 128;
  LAS char* V_lds = (LAS char*)lds; LAS char* K_lds = (LAS char*)lds + NSLOT * SHM_V;
  LAS float* ws = (LAS float*)(lds + NSLOT * (SHM_V + SHM_K)) + wid * 64; LAS float* li_l = ws; LAS float* al_l = ws + 32;
  float m_reg = -1e30f, l_reg = 0; f32x16 o[4] = {}; bf16x8 qr[4];
  const bf16* Qw = Qb + (long)(rg * QBLK + r32) * 512 + map * 64 + hi * 8;
#pragma unroll
  for (int d0 = 0; d0 < 4; ++d0) qr[d0] = *(const bf16x8*)(Qw + d0 * 16);
  const int vb0 = (int)lds0 + v_rd_base(lane);
  unsigned ko0, ko1, vo0;
  { const int r0 = 8 * wid + (lane >> 4), r1 = r0 + 4, cp = lane & 15;
    ko0 = (unsigned)(r0 * LDK + ((cp ^ (r0 & 7)) << 3)) * 2u; ko1 = (unsigned)(r1 * LDK + ((cp ^ (r1 & 7)) << 3)) * 2u;
    const int kk = 8 * wid + ((lane & 31) >> 2), key = kk, c0 = 32 * (lane >> 5) + 8 * (lane & 3);
    vo0 = (unsigned)(key * LDK + c0) * 2u; }
  const unsigned kdst = lds0 + NSLOT * SHM_V + (unsigned)wid * 2048u, vdst = lds0 + (unsigned)wid * 2048u;
#define DA_DMA(t, so) do { const char* kb_ = (const char*)Kh + (size_t)(t) * (KVBLK * LDK * 2); const char* vb_ = (const char*)Vh + (size_t)(t) * (KVBLK * LDK * 2); \
    const unsigned kd_ = (unsigned)__builtin_amdgcn_readfirstlane((int)(kdst + (unsigned)(so))), vd_ = (unsigned)__builtin_amdgcn_readfirstlane((int)(vdst + (unsigned)(so))); \
    glds16s(kb_, ko0, kd_); glds16s(kb_, ko1, kd_ + 1024u); glds16s(vb_, vo0, vd_); glds16s(vb_, vo0 + 128u, vd_ + 1024u); } while (0)
#define DA_VM0() asm volatile("s_waitcnt vmcnt(0)" ::: "memory")
#define DA_RESC(a) do { if (__any((a) < 1.f)) { if (hi == 0) al_l[r32] = (a); asm volatile("s_waitcnt lgkmcnt(0)" ::: "memory"); \
    _Pragma("unroll") for (int d = 0; d < 4; ++d) _Pragma("unroll") for (int r = 0; r < 16; ++r) o[d][r] *= al_l[crow(r, hi)]; } } while (0)
#define DA_BAR() do { asm volatile("s_waitcnt lgkmcnt(0)" ::: "memory"); __builtin_amdgcn_s_barrier(); asm volatile("" ::: "memory"); } while (0)
#define DA_PIN(x) asm volatile("" : "+v"(x))
#define DA_PKF(L, H) (bf16x8){L[0], L[1], L[2], L[3], H[0], H[1], H[2], H[3]}
#define DA_KF(i) (*(const LAS bf16x8*)(kp_ + kxo[(i) >> 1] + ((i) & 1) * 8192))
#define DA_VF(i, L, H) do { L = vtr(vp_ + v_rd_off((i) >> 2, (i) & 3, 0)); H = vtr(vp_ + v_rd_off((i) >> 2, (i) & 3, 1)); } while (0)
#define DA_MX3(a, b, c) fmaxf(fmaxf((a), (b)), (c))
#define DA_EX(v) __builtin_amdgcn_exp2f(v)
#define DA_PKH(P, B, A0, A1, B0, B1) do { A0 = cvtpk(P[B], P[B + 1]); A1 = cvtpk(P[B + 2], P[B + 3]); B0 = cvtpk(P[B + 4], P[B + 5]); B1 = cvtpk(P[B + 6], P[B + 7]); } while (0)
#define DA_PKS(A0, A1, B0, B1, OUT) do { u32x4 w_ = {A0, A1, B0, B1}; OUT = __builtin_bit_cast(bf16x8, w_); } while (0)
#define DA_STEP(PC0, PC1, PN0, PN1, j, FIRST) do { \
    (void)side_step(side, lane);     \
    if constexpr (!(VAR & 1)) { if ((j) + 2 < NT) DA_DMA((j) + 2, s2); } \
    DA_SBAR(); \
    { const LAS char* kp_ = K_lds + s1; bf16x8 k0_ = DA_KF(0), k1_ = DA_KF(1), k2_; unsigned a0_, a1_, b0_, b1_; float sA_ = 0.f, sB_ = 0.f; \
      k2_ = DA_KF(2); PN0 = __builtin_amdgcn_mfma_f32_32x32x16_bf16(k0_, qr[0], negm, 0, 0, 0); sA_ += PC0[0] + PC0[1]; sB_ += PC0[2] + PC0[3]; DA_PKH(PC0, 0, a0_, a1_, b0_, b1_); DA_PIN(sA_); DA_SBAR(); \
      k0_ = DA_KF(3); PN1 = __builtin_amdgcn_mfma_f32_32x32x16_bf16(k1_, qr[0], negm, 0, 0, 0); sA_ += PC0[4] + PC0[5]; sB_ += PC0[6] + PC0[7]; DA_PKS(a0_, a1_, b0_, b1_, pa0); DA_PIN(sB_); DA_SBAR(); \
      k1_ = DA_KF(4); PN0 = __builtin_amdgcn_mfma_f32_32x32x16_bf16(k2_, qr[1], PN0, 0, 0, 0); sA_ += PC0[8] + PC0[9]; sB_ += PC0[10] + PC0[11]; DA_PKH(PC0, 8, a0_, a1_, b0_, b1_); DA_PIN(sA_); DA_SBAR(); \
      k2_ = DA_KF(5); PN1 = __builtin_amdgcn_mfma_f32_32x32x16_bf16(k0_, qr[1], PN1, 0, 0, 0); sA_ += PC0[12] + PC0[13]; sB_ += PC0[14] + PC0[15]; DA_PKS(a0_, a1_, b0_, b1_, pa1); DA_PIN(sB_); DA_SBAR(); \
      k0_ = DA_KF(6); PN0 = __builtin_amdgcn_mfma_f32_32x32x16_bf16(k1_, qr[2], PN0, 0, 0, 0); sA_ += PC1[0] + PC1[1]; sB_ += PC1[2] + PC1[3]; DA_PKH(PC1, 0, a0_, a1_, b0_, b1_); DA_PIN(sA_); DA_SBAR(); \
      k1_ = DA_KF(7); PN1 = __builtin_amdgcn_mfma_f32_32x32x16_bf16(k2_, qr[2], PN1, 0, 0, 0); sA_ += PC1[4] + PC1[5]; sB_ += PC1[6] + PC1[7]; DA_PKS(a0_, a1_, b0_, b1_, pa2); DA_PIN(sB_); DA_SBAR(); \
      PN0 = __builtin_amdgcn_mfma_f32_32x32x16_bf16(k0_, qr[3], PN0, 0, 0, 0); sA_ += PC1[8] + PC1[9]; sB_ += PC1[10] + PC1[11]; DA_PKH(PC1, 8, a0_, a1_, b0_, b1_); DA_PIN(sA_); DA_SBAR(); \
      PN1 = __builtin_amdgcn_mfma_f32_32x32x16_bf16(k1_, qr[3], PN1, 0, 0, 0); sA_ += PC1[12] + PC1[13]; sB_ += PC1[14] + PC1[15]; DA_PKS(a0_, a1_, b0_, b1_, pa3); l_reg += sA_ + sB_; DA_PIN(l_reg); DA_SBAR(); } \
    { const LAS char* vp_ = (const LAS char*)V_lds + vrb + s0; s16x4 l0_, h0_, l1_, h1_, l2_, h2_; float m0_, m1_, m2_, m3_; \
      DA_VF(0, l0_, h0_); DA_VF(1, l1_, h1_); \
      DA_VF(2, l2_, h2_);  o[0] = __builtin_amdgcn_mfma_f32_32x32x16_bf16(pa0, DA_PKF(l0_, h0_), o[0], 0, 0, 0); DA_SBAR(); \
      DA_VF(3, l0_, h0_);  o[0] = __builtin_amdgcn_mfma_f32_32x32x16_bf16(pa1, DA_PKF(l1_, h1_), o[0], 0, 0, 0); \
        m0_ = DA_MX3(PN0[0], PN0[1], PN0[2]); m1_ = DA_MX3(PN0[3], PN0[4], PN0[5]); m2_ = DA_MX3(PN0[6], PN0[7], PN0[8]); m3_ = DA_MX3(PN0[9], PN0[10], PN0[11]); DA_PIN(m0_); DA_SBAR(); \
      DA_VF(4, l1_, h1_);  o[0] = __builtin_amdgcn_mfma_f32_32x32x16_bf16(pa2, DA_PKF(l2_, h2_), o[0], 0, 0, 0); \
        m0_ = DA_MX3(m0_, PN0[12], PN0[13]); m1_ = DA_MX3(m1_, PN0[14], PN0[15]); m2_ = DA_MX3(m2_, PN1[0], PN1[1]); m3_ = DA_MX3(m3_, PN1[2], PN1[3]); DA_PIN(m0_); DA_SBAR(); \
      DA_VF(5, l2_, h2_);  o[0] = __builtin_amdgcn_mfma_f32_32x32x16_bf16(pa3, DA_PKF(l0_, h0_), o[0], 0, 0, 0); \
        m0_ = DA_MX3(m0_, PN1[4], PN1[5]); m1_ = DA_MX3(m1_, PN1[6], PN1[7]); m2_ = DA_MX3(m2_, PN1[8], PN1[9]); m3_ = DA_MX3(m3_, PN1[10], PN1[11]); DA_PIN(m0_); DA_SBAR(); \
      DA_VF(6, l0_, h0_);  o[1] = __builtin_amdgcn_mfma_f32_32x32x16_bf16(pa0, DA_PKF(l1_, h1_), o[1], 0, 0, 0); \
        m0_ = DA_MX3(m0_, PN1[12], PN1[13]); m1_ = DA_MX3(m1_, PN1[14], PN1[15]); float rm_ = fmaxf(fmaxf(m0_, m1_), fmaxf(m2_, m3_)); \
        { auto rr_ = __builtin_amdgcn_permlane32_swap(__float_as_uint(rm_), __float_as_uint(rm_), false, false); rm_ = fmaxf(__uint_as_float(rr_[0]), __uint_as_float(rr_[1])); } DA_PIN(rm_); DA_SBAR(); \
      resc = false; \
      if (__builtin_expect(FIRST || __any(rm_ > THRL), 0)) { const float dl_ = FIRST ? rm_ : fmaxf(rm_, 0.f); mhat += dl_; \
        _Pragma("unroll") for (int r = 0; r < 16; ++r) { PN0[r] -= dl_; PN1[r] -= dl_; } \
        _Pragma("unroll") for (int r = 0; r < 16; ++r) negm[r] = -mhat; DA_PIN(negm); \
        const float f_ = __builtin_amdgcn_exp2f(-dl_); l_reg *= f_; if (hi == 0) al_l[r32] = f_; resc = true; } \
      DA_SBAR(); \
      DA_VF(7, l1_, h1_);  o[1] = __builtin_amdgcn_mfma_f32_32x32x16_bf16(pa1, DA_PKF(l2_, h2_), o[1], 0, 0, 0); PN0[0] = DA_EX(PN0[0]); PN0[1] = DA_EX(PN0[1]); PN0[2] = DA_EX(PN0[2]); DA_PIN(PN0); DA_SBAR(); \
      DA_VF(8, l2_, h2_);  o[1] = __builtin_amdgcn_mfma_f32_32x32x16_bf16(pa2, DA_PKF(l0_, h0_), o[1], 0, 0, 0); PN0[3] = DA_EX(PN0[3]); PN0[4] = DA_EX(PN0[4]); PN0[5] = DA_EX(PN0[5]); DA_PIN(PN0); DA_SBAR(); \
      DA_VF(9, l0_, h0_);  o[1] = __builtin_amdgcn_mfma_f32_32x32x16_bf16(pa3, DA_PKF(l1_, h1_), o[1], 0, 0, 0); PN0[6] = DA_EX(PN0[6]); PN0[7] = DA_EX(PN0[7]); PN0[8] = DA_EX(PN0[8]); DA_PIN(PN0); DA_SBAR(); \
      DA_VF(10, l1_, h1_); o[2] = __builtin_amdgcn_mfma_f32_32x32x16_bf16(pa0, DA_PKF(l2_, h2_), o[2], 0, 0, 0); PN0[9] = DA_EX(PN0[9]); PN0[10] = DA_EX(PN0[10]); PN0[11] = DA_EX(PN0[11]); DA_PIN(PN0); DA_SBAR(); \
      DA_VF(11, l2_, h2_); o[2] = __builtin_amdgcn_mfma_f32_32x32x16_bf16(pa1, DA_PKF(l0_, h0_), o[2], 0, 0, 0); PN0[12] = DA_EX(PN0[12]); PN0[13] = DA_EX(PN0[13]); PN0[14] = DA_EX(PN0[14]); DA_PIN(PN0); DA_SBAR(); \
      DA_VF(12, l0_, h0_); o[2] = __builtin_amdgcn_mfma_f32_32x32x16_bf16(pa2, DA_PKF(l1_, h1_), o[2], 0, 0, 0); PN0[15] = DA_EX(PN0[15]); PN1[0] = DA_EX(PN1[0]); PN1[1] = DA_EX(PN1[1]); DA_PIN(PN0); DA_PIN(PN1); DA_SBAR(); \
      DA_VF(13, l1_, h1_); o[2] = __builtin_amdgcn_mfma_f32_32x32x16_bf16(pa3, DA_PKF(l2_, h2_), o[2], 0, 0, 0); PN1[2] = DA_EX(PN1[2]); PN1[3] = DA_EX(PN1[3]); PN1[4] = DA_EX(PN1[4]); DA_PIN(PN1); DA_SBAR(); \
      DA_VF(14, l2_, h2_); o[3] = __builtin_amdgcn_mfma_f32_32x32x16_bf16(pa0, DA_PKF(l0_, h0_), o[3], 0, 0, 0); PN1[5] = DA_EX(PN1[5]); PN1[6] = DA_EX(PN1[6]); PN1[7] = DA_EX(PN1[7]); DA_PIN(PN1); DA_SBAR(); \
      DA_VF(15, l0_, h0_); o[3] = __builtin_amdgcn_mfma_f32_32x32x16_bf16(pa1, DA_PKF(l1_, h1_), o[3], 0, 0, 0); PN1[8] = DA_EX(PN1[8]); PN1[9] = DA_EX(PN1[9]); PN1[10] = DA_EX(PN1[10]); DA_PIN(PN1); DA_SBAR(); \
                           o[3] = __builtin_amdgcn_mfma_f32_32x32x16_bf16(pa2, DA_PKF(l2_, h2_), o[3], 0, 0, 0); PN1[11] = DA_EX(PN1[11]); PN1[12] = DA_EX(PN1[12]); PN1[13] = DA_EX(PN1[13]); DA_PIN(PN1); DA_SBAR(); \
                           o[3] = __builtin_amdgcn_mfma_f32_32x32x16_bf16(pa3, DA_PKF(l0_, h0_), o[3], 0, 0, 0); PN1[14] = DA_EX(PN1[14]); PN1[15] = DA_EX(PN1[15]); DA_PIN(PN1); DA_SBAR(); } \
    if (resc) { asm volatile("s_waitcnt lgkmcnt(0)" ::: "memory"); \
      _Pragma("unroll") for (int d = 0; d < 4; ++d) _Pragma("unroll") for (int r = 0; r < 16; ++r) o[d][r] *= al_l[crow(r, hi)]; } \
    DA_VM0(); DA_BAR(); \
    { const int t_ = s0; s0 = s1; s1 = s2; s2 = t_; } } while (0)
  f32x16 pA0, pA1, pB0, pB1; bf16x8 pa0, pa1, pa2, pa3; const int NT = seq / KVBLK; const int vrb = v_rd_base(lane);
  int kxo[4];
#pragma unroll
  for (int d0 = 0; d0 < 4; ++d0) kxo[d0] = DA_KSWZ(r32, mb + (d0 * 16 + hi * 8) * 2);
  float mhat = 0.f; bool resc = false; f32x16 negm = f32x16{};
  int s0 = 0, s1 = SHM_V, s2 = 2 * SHM_V;
  DA_DMA(0, 0); DA_DMA(1, SHM_V); DA_VM0(); DA_BAR();
  { float m0 = -1e30f, mn0, al0; qkt(pA0, pA1, K_lds, qr, r32, hi, mb); partialSM(pA0, pA1, m0, mn0, al0);
#pragma unroll
    for (int r = 0; r < 16; ++r) pA1[r] = __builtin_amdgcn_exp2f(pA1[r]);
    mhat = m0;
#pragma unroll
    for (int r = 0; r < 16; ++r) negm[r] = -mhat;
    DA_PIN(negm); }
  int j = 0;
  for (; j + 2 < NT; j += 2) {
    DA_STEP(pA0, pA1, pB0, pB1, j, false);
    DA_STEP(pB0, pB1, pA0, pA1, j + 1, false);
  }
  DA_STEP(pA0, pA1, pB0, pB1, j, false);
  { float sA_ = 0.f; unsigned a0_, a1_, b0_, b1_;
#pragma unroll
    for (int r = 0; r < 16; ++r) sA_ += pB0[r] + pB1[r];
    l_reg += sA_;
    DA_PKH(pB0, 0, a0_, a1_, b0_, b1_); DA_PKS(a0_, a1_, b0_, b1_, pa0); DA_PKH(pB0, 8, a0_, a1_, b0_, b1_); DA_PKS(a0_, a1_, b0_, b1_, pa1);
    DA_PKH(pB1, 0, a0_, a1_, b0_, b1_); DA_PKS(a0_, a1_, b0_, b1_, pa2); DA_PKH(pB1, 8, a0_, a1_, b0_, b1_); DA_PKS(a0_, a1_, b0_, b1_, pa3); }
  DA_SBAR(); pv_d0(o, vb0 + s0, pa0, pa1, pa2, pa3);
  { auto rr = __builtin_amdgcn_permlane32_swap(__float_as_uint(l_reg), __float_as_uint(l_reg), false, false); l_reg = __uint_as_float(rr[0]) + __uint_as_float(rr[1]); }
  if (hi == 0) li_l[r32] = l_reg; asm volatile("s_waitcnt lgkmcnt(0)" ::: "memory");
  float rli[16];
#pragma unroll
  for (int r = 0; r < 16; ++r) rli[r] = __builtin_amdgcn_rcpf(li_l[crow(r, hi)]);
  asm volatile("s_waitcnt vmcnt(0)" ::: "memory");
  __syncthreads();
  LAS float* xch = (LAS float*)lds + rg * 4096 + lane;
  if (map == 1) {
#pragma unroll
    for (int d0 = 0; d0 < 4; ++d0)
#pragma unroll
      for (int r = 0; r < 16; ++r) xch[(d0 * 16 + r) * 64] = o[d0][r] * (rli[r] * lam);
  }
  asm volatile("s_waitcnt lgkmcnt(0)" ::: "memory");
  __syncthreads();
  if (map == 0) {
    float ss[16];
#pragma unroll
    for (int r = 0; r < 16; ++r) ss[r] = 0.f;
#pragma unroll
    for (int d0 = 0; d0 < 4; ++d0)
#pragma unroll
      for (int r = 0; r < 16; ++r) { const float v = o[d0][r] * rli[r] - xch[(d0 * 16 + r) * 64]; o[d0][r] = v; ss[r] += v * v; }
#pragma unroll
    for (int r = 0; r < 16; ++r) { float s = ss[r]; s += __shfl_xor(s, 1); s += __shfl_xor(s, 2); s += __shfl_xor(s, 4); s += __shfl_xor(s, 8); s += __shfl_xor(s, 16);
      ss[r] = __builtin_amdgcn_rsqf(s * (1.f / 128.f) + 1e-6f); }
    bf16* Ow = Ob + (long)(rg * QBLK) * ldo + r32;
#pragma unroll
    for (int r = 0; r < 16; ++r) { const int orow = crow(r, hi);
#pragma unroll
      for (int d0 = 0; d0 < 4; ++d0) { const unsigned w = cvtpk(o[d0][r] * ss[r] * gs[d0], 0.f); Ow[(long)orow * ldo + d0 * 32] = (bf16)(w & 0xffffu); } }
  }
  asm volatile("s_waitcnt lgkmcnt(0)" ::: "memory");
  __syncthreads();
#undef DA_DMA
#undef DA_VM0
#undef DA_PIN
#undef DA_PKF
#undef DA_KF
#undef DA_VF
#undef DA_MX3
#undef DA_EX
#undef DA_PKH
#undef DA_PKS
#undef DA_RESC
#undef DA_BAR
#undef DA_STEP
}
#undef DA_KSWZ
#undef DA_SBAR
}
namespace fft {
using bf16x8 = __attribute__((ext_vector_type(8))) short;
using f32x4v = __attribute__((ext_vector_type(4))) float;
using u32x4 = __attribute__((ext_vector_type(4))) unsigned;
constexpr int XROW = 272;
constexpr int LDS_FFT = 4 * 64 * XROW;
__device__ __forceinline__ unsigned cvtpk(float lo, float hi) { typedef float f32x2_t __attribute__((ext_vector_type(2))); typedef __bf16 bf16x2_t __attribute__((ext_vector_type(2))); const f32x2_t v = {lo, hi}; return __builtin_bit_cast(unsigned, __builtin_convertvector(v, bf16x2_t)); }
__device__ __forceinline__ void fft_unit(const bf16* __restrict__ xg, bf16* __restrict__ out, int ldo, const bf16* __restrict__ F1T, const float2* __restrict__ TW, const bf16* __restrict__ F2P, LAS unsigned char* lds) {
  const int tid = threadIdx.x, lane = tid & 63, wave = __builtin_amdgcn_readfirstlane(tid >> 6), l16 = lane & 15, quad = lane >> 4;
#pragma unroll
  for (int it = 0; it < 8; ++it) { const int p = it * 512 + tid, n = 2 * p, n1 = n >> 6, n2 = n & 63;
    const uint4 v = ((const uint4*)xg)[p];
    LAS unsigned short* b0 = (LAS unsigned short*)(lds + n2 * XROW + n1 * 2);
    b0[(0 * 64) * (XROW / 2)] = (unsigned short)(v.x & 0xffffu); b0[(1 * 64) * (XROW / 2)] = (unsigned short)(v.x >> 16);
    b0[(2 * 64) * (XROW / 2)] = (unsigned short)(v.y & 0xffffu); b0[(3 * 64) * (XROW / 2)] = (unsigned short)(v.y >> 16);
    b0[(0 * 64 + 1) * (XROW / 2)] = (unsigned short)(v.z & 0xffffu); b0[(1 * 64 + 1) * (XROW / 2)] = (unsigned short)(v.z >> 16);
    b0[(2 * 64 + 1) * (XROW / 2)] = (unsigned short)(v.w & 0xffffu); b0[(3 * 64 + 1) * (XROW / 2)] = (unsigned short)(v.w >> 16); }
  bf16x8 f1[2][4]; float2 tw[4][4];
#pragma unroll
  for (int part = 0; part < 2; ++part)
#pragma unroll
    for (int s = 0; s < 4; ++s) f1[part][s] = *(const bf16x8*)(F1T + ((size_t)(part * 128 + 16 * wave + l16) * 128 + 32 * s + 8 * quad));
#pragma unroll
  for (int t = 0; t < 4; ++t)
#pragma unroll
    for (int j = 0; j < 4; ++j) tw[t][j] = TW[(16 * t + 4 * quad + j) * 128 + 16 * wave + l16];
  asm volatile("s_waitcnt lgkmcnt(0)" ::: "memory");
  __syncthreads();
  bf16x8 A2[4][2][2];
#pragma unroll
  for (int c = 0; c < 4; ++c) {
    f32x4v acc[4][2];
#pragma unroll
    for (int t = 0; t < 4; ++t) { acc[t][0] = (f32x4v){0.f, 0.f, 0.f, 0.f}; acc[t][1] = (f32x4v){0.f, 0.f, 0.f, 0.f}; }
#pragma unroll
    for (int t = 0; t < 4; ++t)
#pragma unroll
      for (int s = 0; s < 4; ++s) { const bf16x8 a = *(const LAS bf16x8*)(lds + (c * 64 + 16 * t + l16) * XROW + (32 * s + 8 * quad) * 2);
        acc[t][0] = __builtin_amdgcn_mfma_f32_16x16x32_bf16(a, f1[0][s], acc[t][0], 0, 0, 0);
        acc[t][1] = __builtin_amdgcn_mfma_f32_16x16x32_bf16(a, f1[1][s], acc[t][1], 0, 0, 0); }
    f32x4v pr[4], pi[4];
#pragma unroll
    for (int t = 0; t < 4; ++t)
#pragma unroll
      for (int j = 0; j < 4; ++j) { const float tr = acc[t][0][j], ti = acc[t][1][j]; const float2 w = tw[t][j]; pr[t][j] = tr * w.x - ti * w.y; pi[t][j] = tr * w.y + ti * w.x; }
#pragma unroll
    for (int sp = 0; sp < 2; ++sp) {
      u32x4 wr_ = {cvtpk(pr[2 * sp][0], pr[2 * sp][1]), cvtpk(pr[2 * sp][2], pr[2 * sp][3]), cvtpk(pr[2 * sp + 1][0], pr[2 * sp + 1][1]), cvtpk(pr[2 * sp + 1][2], pr[2 * sp + 1][3])};
      u32x4 wi_ = {cvtpk(pi[2 * sp][0], pi[2 * sp][1]), cvtpk(pi[2 * sp][2], pi[2 * sp][3]), cvtpk(pi[2 * sp + 1][0], pi[2 * sp + 1][1]), cvtpk(pi[2 * sp + 1][2], pi[2 * sp + 1][3])};
      A2[c][0][sp] = __builtin_bit_cast(bf16x8, wr_); A2[c][1][sp] = __builtin_bit_cast(bf16x8, wi_); }
  }
#pragma unroll
  for (int v = 0; v < 4; ++v) {
    bf16x8 bc[2], bs[2], bn[2];
#pragma unroll
    for (int sp = 0; sp < 2; ++sp) { const size_t o = (size_t)(16 * v + l16) * 64 + sp * 32 + quad * 8;
      bc[sp] = *(const bf16x8*)(F2P + o); bs[sp] = *(const bf16x8*)(F2P + 4096 + o); bn[sp] = *(const bf16x8*)(F2P + 8192 + o); }
    f32x4v dr[4], di[4];
#pragma unroll
    for (int c = 0; c < 4; ++c) { dr[c] = (f32x4v){0.f, 0.f, 0.f, 0.f}; di[c] = (f32x4v){0.f, 0.f, 0.f, 0.f};
#pragma unroll
      for (int sp = 0; sp < 2; ++sp) {
        dr[c] = __builtin_amdgcn_mfma_f32_16x16x32_bf16(A2[c][0][sp], bc[sp], dr[c], 0, 0, 0);
        dr[c] = __builtin_amdgcn_mfma_f32_16x16x32_bf16(A2[c][1][sp], bs[sp], dr[c], 0, 0, 0);
        di[c] = __builtin_amdgcn_mfma_f32_16x16x32_bf16(A2[c][0][sp], bn[sp], di[c], 0, 0, 0);
        di[c] = __builtin_amdgcn_mfma_f32_16x16x32_bf16(A2[c][1][sp], bc[sp], di[c], 0, 0, 0); } }
#pragma unroll
    for (int j = 0; j < 4; ++j) { const int tok = 16 * wave + 4 * quad + j + 128 * (16 * v + l16);
      u32x4 w = {cvtpk(dr[0][j], di[0][j]), cvtpk(dr[1][j], di[1][j]), cvtpk(dr[2][j], di[2][j]), cvtpk(dr[3][j], di[3][j])};
      *(u32x4*)(out + (size_t)tok * ldo) = w; }
  }
  __syncthreads();
}
}
constexpr int NWAVES = 8;
constexpr int RING_OFF = 0, RING_BYTES = 131072;
constexpr int LDSX_OFF = 163840 - 8192;
constexpr int MISC_OFF = LDSX_OFF, TB_OFF = LDSX_OFF + 512, TOKS_OFF = LDSX_OFF + 1024;
constexpr int LDS_BYTES = 163840;
static_assert(TOKS_OFF + 4 * 256 * 4 <= LDS_BYTES, "LDS map");
constexpr int CW_BAR = 4096;
namespace thin {
typedef float f32x4 __attribute__((ext_vector_type(4)));
typedef float f32x2 __attribute__((ext_vector_type(2)));
typedef unsigned u32x4 __attribute__((ext_vector_type(4)));
typedef unsigned u32x2 __attribute__((ext_vector_type(2)));
typedef short bf16x8 __attribute__((ext_vector_type(8)));
__device__ __forceinline__ unsigned pk2(float lo, float hi) { typedef float f32x2_t __attribute__((ext_vector_type(2))); typedef __bf16 bf16x2_t __attribute__((ext_vector_type(2))); const f32x2_t v = {lo, hi}; return __builtin_bit_cast(unsigned, __builtin_convertvector(v, bf16x2_t)); }
__device__ __forceinline__ float wave_sum(float v) {
#pragma unroll
    for (int o = 1; o < 64; o <<= 1) v += __shfl_xor(v, o);
    return v;
}
__device__ __forceinline__ void transpose_item(const float* W, int N, bf16* WT, int ldo, int mode, LAS float* scr, int item, int lane) {
    const int nblk = N / 32, kb = item / nblk, nb = item % nblk, k0 = 64 * kb, n0 = 32 * nb;
#pragma unroll 8
    for (int i = 0; i < 32; ++i) { const int kk = 2 * i + (lane >> 5); scr[kk * 33 + (lane & 31)] = W[(size_t)(k0 + kk) * N + n0 + (lane & 31)]; }
    LDS_WAIT(); asm volatile("" ::: "memory");
    const int c = lane & 7;
#pragma unroll
    for (int j = 0; j < 4; ++j) { const int nl = (lane >> 3) + 8 * j, n = n0 + nl; const LAS float* s = scr + (8 * c) * 33 + nl;
        const int row = mode == 0 ? n : ((n >> 4) * 32 + (n & 15) + (mode == 2 ? 16 : 0));
        u32x4 o; o.x = pk2(s[0 * 33], s[1 * 33]); o.y = pk2(s[2 * 33], s[3 * 33]); o.z = pk2(s[4 * 33], s[5 * 33]); o.w = pk2(s[6 * 33], s[7 * 33]);
        *(u32x4*)(WT + (size_t)row * ldo + k0 + 8 * c) = o; }
    LDS_WAIT(); asm volatile("" ::: "memory");
}
struct P0Args { const float *c, *cctx, *w_ada, *b_ada, *w_in, *w_out, *w_gate, *w_up, *w_down, *wfour, *wrg, *wre; float *modv, *rope, *cs; bf16 *f1t; float2* tw; bf16 *f2p, *wrf, *win_t, *wout_t, *wgu, *wd; };
__device__ __forceinline__ void p0_prologue(const P0Args& a, LAS unsigned char* lds, int bx, int G, int tid, int lane, int wave) {
    for (int u = bx; u < 192; u += G) {
        const int col0 = u * 32, c4 = tid & 7, kk = tid >> 3;
        f32x4 acc[3] = {};
#pragma unroll 4
        for (int i = 0; i < 16; ++i) { const int k = kk + 64 * i; const f32x4 w = *(const f32x4*)(a.w_ada + (size_t)k * 6144 + col0 + 4 * c4);
#pragma unroll
            for (int v = 0; v < 3; ++v) { const float s = v < 2 ? a.c[v * D + k] : a.cctx[k]; acc[v] += (s / (1.f + expf(-s))) * w; } }
        LAS f32x4* red = (LAS f32x4*)lds;
#pragma unroll
        for (int v = 0; v < 3; ++v) red[(kk * 3 + v) * 8 + c4] = acc[v];
        __syncthreads();
        if (tid < 96) { const int v = tid >> 5, col = tid & 31; float s = a.b_ada[col0 + col];
            for (int q = 0; q < 64; ++q) s += ((LAS float*)lds)[((q * 3 + v) * 8) * 4 + col];
            a.modv[v * 6144 + col0 + col] = s; }
        __syncthreads();
    }
    const int gt = bx * 512 + tid, NT = G * 512;
    for (int t = gt; t < 2048; t += NT) { const int pos = t >> 4, i = t & 15; const float inv = powf(10000.f, -(float)(2 * i) / 32.f), ang = (float)pos * inv; a.rope[t] = cosf(ang); a.rope[2048 + t] = sinf(ang); }
    for (int t = gt; t < 32768; t += NT) {
        { const int part = t >> 14, k1 = (t >> 7) & 127, n1 = t & 127; const float x = (float)((k1 * n1) & 127) / 64.f; a.f1t[t] = (bf16)(pk2(part ? -sinpif(x) : cospif(x), 0.f) & 0xffffu); }
        if (t < 8192) { const int n2 = t >> 7, k1 = t & 127; const float x = (float)(n2 * k1) / 4096.f; a.tw[t] = make_float2(cospif(x), -sinpif(x)); }
        if (t < 12288) { const int tab = t >> 12, k2 = (t >> 6) & 63, pos = t & 63, sp = pos >> 5, quad = (pos >> 3) & 3, jj = pos & 7;
            const int n2 = 32 * sp + (jj < 4 ? 4 * quad + jj : 16 + 4 * quad + (jj - 4)); const float x = (float)((n2 * k2) & 63) / 32.f;
            a.f2p[t] = (bf16)(pk2(tab == 0 ? cospif(x) : (tab == 1 ? sinpif(x) : -sinpif(x)), 0.f) & 0xffffu); } }
    for (int t = gt; t < 32 * 3 * 2 * 64 * 8; t += NT) { const int j = t & 7, ln = (t >> 3) & 63, hl = (t >> 9) & 1, nt = (t >> 10) % 3, s = t / 3072;
        const int k = 32 * s + 8 * (ln >> 4) + j, e = 16 * nt + (ln & 15);
        const float w = e < 4 ? a.wrg[k * 4 + e] : (e < 36 ? a.wre[k * 32 + (e - 4)] : 0.f);
        const unsigned hi = pk2(w, 0.f) & 0xffffu; const float lo = w - __uint_as_float(hi << 16);
        a.wrf[t] = (bf16)(hl ? (pk2(lo, 0.f) & 0xffffu) : hi); }
    { LAS float* tr = (LAS float*)lds;
      if (tid < 128) { tr[tid] = cospif((float)tid / 64.f); tr[128 + tid] = sinpif((float)tid / 64.f); }
      __syncthreads();
      for (int t = gt; t < 131072; t += NT) { const int d = t & 127, c = (t >> 7) & 127, part = (t >> 14) & 1, g = t >> 15; float acc = 0.f;
#pragma unroll 8
          for (int kap = 0; kap < 128; ++kap) acc += tr[part * 128 + ((c * kap) & 127)] * a.wfour[((size_t)g * 128 + kap) * 128 + d];
          a.cs[t] = acc * (1.0f / 1024.0f); }
      __syncthreads(); }
    { LAS float* scr = (LAS float*)(lds + wave * 16384);
      const int gw = bx * 8 + wave, NGW = G * 8;
      constexpr int I_IN = 16 * 64, I_OUT = 8 * 32, NITEMS = I_IN + I_OUT;
      for (int it = gw; it < NITEMS; it += NGW) { int r = it;
          if (r < I_IN) { transpose_item(a.w_in, 2048, a.win_t, D, 0, scr, r, lane); continue; } r -= I_IN;
          transpose_item(a.w_out, D, a.wout_t, KO, 0, scr, r, lane); } }
}
__device__ __forceinline__ void p1_norms(const float* x, const float* ctx, const float* gmix, const float* modv, bf16* hl, const float* cs, const float* w_out, bf16* wout_t,
                                         LAS unsigned char* lds, int bx, int G, int tid, int lane, int wave) {
    for (int u = bx; u < 256; u += G) {
        const int g = u >> 6, kb = u & 63; LAS float* csl = (LAS float*)lds;
        { const int i = tid >> 7, d = tid & 127; csl[tid] = cs[(((size_t)g * 2 + (i & 1)) * 128 + 2 * kb + (i >> 1)) * 128 + d]; }
        __syncthreads();
        f32x2 acc[4] = {};
        const float* wp = w_out + (size_t)(512 + g * 128) * D + 2 * tid;
#pragma unroll 1
        for (int d0 = 0; d0 < 128; d0 += 16) { f32x2 w2[16];
#pragma unroll
            for (int q = 0; q < 16; ++q) w2[q] = *(const f32x2*)(wp + (size_t)(d0 + q) * D);
#pragma unroll
            for (int q = 0; q < 16; ++q)
#pragma unroll
                for (int i = 0; i < 4; ++i) acc[i] += csl[i * 128 + d0 + q] * w2[q]; }
#pragma unroll
        for (int h = 0; h < 2; ++h) { u32x2 o; o.x = pk2(acc[0][h], acc[1][h]); o.y = pk2(acc[2][h], acc[3][h]);
            *(u32x2*)(wout_t + (size_t)(2 * tid + h) * KO + 512 + g * 256 + 4 * kb) = o; }
        __syncthreads();
    }
    const int gw = bx * 8 + wave, NGW = G * 8;
    for (int row0 = gw; row0 < M + 512; row0 += 2 * NGW) {
        const int row1 = row0 + NGW; const bool has1 = row1 < M + 512;
        const float* src0 = row0 < M ? x + (size_t)row0 * D : ctx + (size_t)(row0 - M) * D;
        const float* src1 = !has1 ? src0 : (row1 < M ? x + (size_t)row1 * D : ctx + (size_t)(row1 - M) * D);
        f32x4 v0[4], v1[4]; float ss0 = 0.f, ss1 = 0.f;
#pragma unroll
        for (int j = 0; j < 4; ++j) { v0[j] = ((const f32x4*)src0)[lane + 64 * j]; v1[j] = ((const f32x4*)src1)[lane + 64 * j]; }
#pragma unroll
        for (int j = 0; j < 4; ++j) { ss0 += (v0[j].x * v0[j].x + v0[j].y * v0[j].y) + (v0[j].z * v0[j].z + v0[j].w * v0[j].w); ss1 += (v1[j].x * v1[j].x + v1[j].y * v1[j].y) + (v1[j].z * v1[j].z + v1[j].w * v1[j].w); }
#pragma unroll
        for (int o = 1; o < 64; o <<= 1) { ss0 += __shfl_xor(ss0, o); ss1 += __shfl_xor(ss1, o); }
        const float rs0 = rsqrtf(ss0 * (1.f / D) + EPS), rs1 = rsqrtf(ss1 * (1.f / D) + EPS);
        const float* mv0 = modv + (row0 < M ? (row0 >> 13) : 2) * 6144; const float* mv1 = modv + (row1 < M ? (row1 >> 13) : 2) * 6144;
#pragma unroll
        for (int j = 0; j < 4; ++j) { const int k = 4 * lane + 256 * j; const f32x4 gv = *(const f32x4*)(gmix + k);
            { const f32x4 sh = *(const f32x4*)(mv0 + k), sc = *(const f32x4*)(mv0 + 1024 + k); const f32x4 o = (v0[j] * rs0 * gv) * (1.f + sc) + sh; u32x2 w; w.x = pk2(o.x, o.y); w.y = pk2(o.z, o.w); *(u32x2*)(hl + (size_t)row0 * D + k) = w; }
            if (has1) { const f32x4 sh = *(const f32x4*)(mv1 + k), sc = *(const f32x4*)(mv1 + 1024 + k); const f32x4 o = (v1[j] * rs1 * gv) * (1.f + sc) + sh; u32x2 w; w.x = pk2(o.x, o.y); w.y = pk2(o.z, o.w); *(u32x2*)(hl + (size_t)row1 * D + k) = w; } }
    }
}
__device__ __forceinline__ void ctx_proj(const bf16* hc, const bf16* win_t, bf16* Kb, bf16* Vb, int bx, int G, int lane, int wave) {
    const int l16 = lane & 15, quad = lane >> 4;
    for (int u = bx; u < 256; u += G) {
        const int row = 32 * (u >> 4) + 16 * (wave >> 2) + l16, col = 64 * (u & 15) + 16 * (wave & 3) + l16;
        const bf16* ap = hc + (size_t)row * D + 8 * quad; const bf16* bp = win_t + (size_t)(512 + col) * D + 8 * quad;
        f32x4 acc = {0.f, 0.f, 0.f, 0.f};
#pragma unroll 8
        for (int s = 0; s < 32; ++s) acc = __builtin_amdgcn_mfma_f32_16x16x32_bf16(*(const bf16x8*)(ap + 32 * s), *(const bf16x8*)(bp + 32 * s), acc, 0, 0, 0);
#pragma unroll
        for (int j = 0; j < 4; ++j) { const int r = 32 * (u >> 4) + 16 * (wave >> 2) + 4 * quad + j, b = r >> 8, jr = r & 255;
            bf16* dst = col < 512 ? Kb : Vb; dst[((size_t)b * KV + jr) * 512 + (col & 511)] = (bf16)(pk2(acc[j], 0.f) & 0xffffu); }
    }
}
__device__ __forceinline__ void p5_router(const float* xl, const float* ssq, const float* gffn, const float* modv, const bf16* wrf, const float* brg, const float* bre,
                                          bf16* h2, unsigned* cnt, int* tokof, int* expid, int* posb, float* gate, LAS unsigned char* lds, int bx, int G, int tid, int lane, int wave) {
    const int l16 = lane & 15, quad = lane >> 4, grp = wave & 3, kh = wave >> 2;
    LAS float* LG = (LAS float*)lds;
    LAS int* hist = (LAS int*)(lds + 32768); LAS int* base = hist + 32;
    for (int tbk = bx; tbk < M / 64; tbk += G) {
        const int token = tbk * 64 + 16 * grp + l16, b = token >> 13; const float* mv = modv + b * 6144;
        float tot = 0.f;
#pragma unroll
        for (int q = 0; q < 4; ++q) { const f32x4 p = *(const f32x4*)(ssq + (size_t)token * 16 + 4 * q); tot += (p.x + p.y) + (p.z + p.w); }
        const float rs = rsqrtf(tot * (1.f / D) + EPS);
        f32x4 acc[3] = {};
        if (tid < 32) hist[tid] = 0;
#pragma unroll 4
        for (int s = kh * 16; s < kh * 16 + 16; ++s) { const int k0 = 32 * s + 8 * quad; float hv[8];
#pragma unroll
            for (int q = 0; q < 2; ++q) { const f32x4 xv = *(const f32x4*)(xl + (size_t)token * D + k0 + 4 * q), gv = *(const f32x4*)(gffn + k0 + 4 * q), sc = *(const f32x4*)(mv + 4096 + k0 + 4 * q), sh = *(const f32x4*)(mv + 3072 + k0 + 4 * q);
                const f32x4 o = (xv * rs * gv) * (1.f + sc) + sh; hv[4 * q] = o.x; hv[4 * q + 1] = o.y; hv[4 * q + 2] = o.z; hv[4 * q + 3] = o.w; }
            u32x4 hi, lo;
#pragma unroll
            for (int q = 0; q < 4; ++q) { const unsigned w = pk2(hv[2 * q], hv[2 * q + 1]); hi[q] = w;
                lo[q] = pk2(hv[2 * q] - __uint_as_float(w << 16), hv[2 * q + 1] - __uint_as_float(w & 0xffff0000u)); }
            *(u32x4*)(h2 + (size_t)token * D + k0) = hi;
            const bf16x8 ah = __builtin_bit_cast(bf16x8, hi), al = __builtin_bit_cast(bf16x8, lo);
#pragma unroll
            for (int nt = 0; nt < 3; ++nt) { const bf16x8 bh = *(const bf16x8*)(wrf + ((size_t)((s * 3 + nt) * 2 + 0) * 64 + lane) * 8), bl = *(const bf16x8*)(wrf + ((size_t)((s * 3 + nt) * 2 + 1) * 64 + lane) * 8);
                acc[nt] = __builtin_amdgcn_mfma_f32_16x16x32_bf16(ah, bh, acc[nt], 0, 0, 0);
                acc[nt] = __builtin_amdgcn_mfma_f32_16x16x32_bf16(ah, bl, acc[nt], 0, 0, 0);
                acc[nt] = __builtin_amdgcn_mfma_f32_16x16x32_bf16(al, bh, acc[nt], 0, 0, 0); } }
#pragma unroll
        for (int nt = 0; nt < 3; ++nt)
#pragma unroll
            for (int j = 0; j < 4; ++j) LG[((kh * 4 + grp) * 16 + 4 * quad + j) * 48 + 16 * nt + l16] = acc[nt][j];
        __syncthreads();
        int ex0 = 0, ex1 = 0, lp0 = 0, lp1 = 0; float g0 = 0.f, g1 = 0.f;
        if (tid < 64) {
            const LAS float* p0 = LG + (size_t)tid * 48; const LAS float* p1 = LG + (size_t)(64 + tid) * 48; float lg[36];
#pragma unroll
            for (int e = 0; e < 36; ++e) lg[e] = p0[e] + p1[e] + (e < 4 ? brg[e] : bre[e - 4]);
            int grpi = 0; float gm = lg[0];
#pragma unroll
            for (int i = 1; i < 4; ++i) if (lg[i] > gm) { gm = lg[i]; grpi = i; }
            float se = 0.f;
#pragma unroll
            for (int i = 0; i < 4; ++i) se += expf(lg[i] - gm);
            const float pg = 1.f / se;
            float el[8];
#pragma unroll
            for (int i = 0; i < 8; ++i) el[i] = grpi == 0 ? lg[4 + i] : (grpi == 1 ? lg[12 + i] : (grpi == 2 ? lg[20 + i] : lg[28 + i]));
            int i0 = 0; float v0 = el[0];
#pragma unroll
            for (int i = 1; i < 8; ++i) if (el[i] > v0) { v0 = el[i]; i0 = i; }
            int i1 = -1; float v1 = -3.0e38f;
#pragma unroll
            for (int i = 0; i < 8; ++i) if (i != i0 && el[i] > v1) { v1 = el[i]; i1 = i; }
            const float e1 = expf(v1 - v0); g0 = pg / (1.f + e1); g1 = pg * e1 / (1.f + e1);
            ex0 = grpi * 8 + i0; ex1 = grpi * 8 + i1;
            lp0 = __hip_atomic_fetch_add(hist + ex0, 1, __ATOMIC_RELAXED, __HIP_MEMORY_SCOPE_WORKGROUP); lp1 = __hip_atomic_fetch_add(hist + ex1, 1, __ATOMIC_RELAXED, __HIP_MEMORY_SCOPE_WORKGROUP);
        }
        __syncthreads();
        if (tid < 32) { const int n = hist[tid]; base[tid] = n > 0 ? (int)atomicAdd(&cnt[tid * 64], (unsigned)n) : 0; }
        __syncthreads();
        if (tid < 64) { const int tk = tbk * 64 + tid, q0 = base[ex0] + lp0, q1 = base[ex1] + lp1;
            tokof[ex0 * 16384 + q0] = tk; tokof[ex1 * 16384 + q1] = tk;
            expid[tk * 2] = ex0; expid[tk * 2 + 1] = ex1; posb[tk * 2] = q0; posb[tk * 2 + 1] = q1; gate[tk * 2] = g0; gate[tk * 2 + 1] = g1; }
        __syncthreads();
    }
}
__device__ __forceinline__ void p8_final(const bf16* ybuf, const int* expid, const int* posb, const float* gate, const float* modv, const float* gfin, float* out, const LAS int* tb, int bx, int G, int lane, int wave) {
    const int gw = bx * 8 + wave, NGW = G * 8;
#define P8_LOAD(row, v, ss) do { const u32x2 ei_ = *(const u32x2*)(expid + (row) * 2), pi_ = *(const u32x2*)(posb + (row) * 2); const f32x2 gg_ = *(const f32x2*)(gate + (row) * 2); \
        const bf16* y0_ = ybuf + (size_t)(tb[ei_.x] * 256 + (int)pi_.x) * D; const bf16* y1_ = ybuf + (size_t)(tb[ei_.y] * 256 + (int)pi_.y) * D; const float* gt2_ = modv + ((row) >> 13) * 6144 + 5120; \
        _Pragma("unroll") for (int j = 0; j < 4; ++j) { const int k = 4 * lane + 256 * j; const f32x4 xv = *(const f32x4*)(out + (size_t)(row) * D + k), gv = *(const f32x4*)(gt2_ + k); \
            const u32x2 a = *(const u32x2*)(y0_ + k), c = *(const u32x2*)(y1_ + k); \
            const f32x4 ya = {__uint_as_float(a.x << 16), __uint_as_float(a.x & 0xffff0000u), __uint_as_float(a.y << 16), __uint_as_float(a.y & 0xffff0000u)}; \
            const f32x4 yc = {__uint_as_float(c.x << 16), __uint_as_float(c.x & 0xffff0000u), __uint_as_float(c.y << 16), __uint_as_float(c.y & 0xffff0000u)}; \
            v[j] = xv + gv * (gg_.x * ya + gg_.y * yc); ss += (v[j].x * v[j].x + v[j].y * v[j].y) + (v[j].z * v[j].z + v[j].w * v[j].w); } } while (0)
    for (int row0 = gw; row0 < M; row0 += 2 * NGW) {
        const int row1 = row0 + NGW; const bool has1 = row1 < M; const int r1 = has1 ? row1 : row0;
        f32x4 v0[4], v1[4]; float ss0 = 0.f, ss1 = 0.f;
        P8_LOAD(row0, v0, ss0); P8_LOAD(r1, v1, ss1);
#pragma unroll
        for (int o = 1; o < 64; o <<= 1) { ss0 += __shfl_xor(ss0, o); ss1 += __shfl_xor(ss1, o); }
        const float rs0 = rsqrtf(ss0 * (1.f / D) + EPS), rs1 = rsqrtf(ss1 * (1.f / D) + EPS);
#pragma unroll
        for (int j = 0; j < 4; ++j) { const int k = 4 * lane + 256 * j; const f32x4 gf = *(const f32x4*)(gfin + k);
            *(f32x4*)(out + (size_t)row0 * D + k) = v0[j] * rs0 * gf; if (has1) *(f32x4*)(out + (size_t)row1 * D + k) = v1[j] * rs1 * gf; }
    }
#undef P8_LOAD
}
}
struct Args { const float* in[24]; float* out; unsigned char* ws; int ph_lo, ph_hi, li, pad; };
__global__ void __launch_bounds__(NWAVES * 64, 2) mk_fwd(Args args) {
    extern __shared__ __attribute__((aligned(16))) unsigned char lds_raw[];
    LAS unsigned char* lds = (LAS unsigned char*)lds_raw;
    volatile LAS unsigned* MISC = (volatile LAS unsigned*)(lds + MISC_OFF);
    const int tid = threadIdx.x, lane = tid & 63, wave = __builtin_amdgcn_readfirstlane(tid >> 6);
    const int G = gridDim.x, bx = blockIdx.x;
    unsigned char* ws = args.ws;
    unsigned* ctl = (unsigned*)(ws + WS_CTL);
    if (tid < 32) MISC[tid] = 0u;
    __syncthreads();
    const int lo = args.ph_lo, hi = args.ph_hi;
    XcdBarrier bar; bar.bar = ctl + CW_BAR + args.li * XCD_BAR_WORDS; bar.x = 0; bar.st = nullptr;
    if (hi - lo > 1) bar = xcd_barrier_post(ctl + CW_BAR + args.li * XCD_BAR_WORDS, MISC + 8);
#ifndef PH_ENABLE
#define PH_ENABLE 0x1FF
#endif
#define IN(k) (((PH_ENABLE >> (k)) & 1) && lo <= (k) && (k) < hi)
#define SEAM(k) do { if (IN(k) && IN((k) + 1)) xcd_barrier(bar); } while (0)
    bf16* win_t = (bf16*)(ws + WS_WIN_T); bf16* wout_t = (bf16*)(ws + WS_WOUT_T); bf16* wgu = (bf16*)(ws + WS_WGU); bf16* wd = (bf16*)(ws + WS_WD);
    bf16* hl = (bf16*)(ws + WS_HL); bf16* amix = (bf16*)(ws + WS_AMIX); bf16* ybuf = (bf16*)(ws + WS_YBUF);
    bf16* Q = (bf16*)(ws + WS_Q); bf16* Kb = (bf16*)(ws + WS_K); bf16* Vb = (bf16*)(ws + WS_V); bf16* F = (bf16*)(ws + WS_F);
    bf16* h2 = (bf16*)(ws + WS_H2); bf16* hmid = (bf16*)(ws + WS_HMID);
    float* modv = (float*)(ws + WS_MOD); float* rope = (float*)(ws + WS_ROPE); float* ssq = (float*)(ws + WS_SSQ);
    float* xl = args.out;

    int* tokof = (int*)(ws + WS_TOKOF); int* expid = (int*)(ws + WS_RT); int* posb = expid + M * 2; float* gate = (float*)(posb + M * 2);
    unsigned* cnt = ctl + CW_CNT;
    if (IN(0)) {
        thin::P0Args a{args.in[1], args.in[3], args.in[4], args.in[5], args.in[8], args.in[15], args.in[20], args.in[21], args.in[22], args.in[14], args.in[16], args.in[18],
                       modv, rope, (float*)(ws + WS_CS), (bf16*)(ws + WS_F1T), (float2*)(ws + WS_TW), (bf16*)(ws + WS_F2P), (bf16*)(ws + WS_WRF), win_t, wout_t, wgu, wd};
        thin::p0_prologue(a, lds + RING_OFF, bx, G, tid, lane, wave);
    }
    SEAM(0);
    if (IN(1)) thin::p1_norms(args.in[0], args.in[2], args.in[6], modv, hl, (const float*)(ws + WS_CS), args.in[15], wout_t, lds + RING_OFF, bx, G, tid, lane, wave);
    SEAM(1);
    if (IN(2)) {
        thin::ctx_proj(hl + (size_t)M * D, win_t, Kb, Vb, bx, G, lane, wave);
        pg8::Gemm g{hl, win_t, M, 2048, D}; pg8::StaticOrder S; S.init(M, 2048, G, bx);
        pg8::EpiInProj E{Q, Kb, Vb, F, rope};
        pg8::gemm_phase<pg8::EpiInProj, pg8::StaticOrder, true, true>(lds + RING_OFF, g, S, E);
    }
    SEAM(2);
    if (IN(3)) {
        const float* lq1 = args.in[9]; const float* lk1 = args.in[10]; const float* lq2 = args.in[11]; const float* lk2 = args.in[12]; const float* gsub = args.in[13];
        float a1 = lq1[lane] * lk1[lane], a2 = lq2[lane] * lk2[lane];
#pragma unroll
        for (int o = 1; o < 64; o <<= 1) { a1 += __shfl_xor(a1, o); a2 += __shfl_xor(a2, o); }
        const float lam = expf(a1) - expf(a2) + 0.2f;
        float gs[4];
#pragma unroll
        for (int d0 = 0; d0 < 4; ++d0) gs[d0] = gsub[32 * d0 + (lane & 31)] * 0.8f;
        const unsigned lds0 = (unsigned)(uintptr_t)lds_raw + RING_OFF;
        da::SideCvt side;
        side.w_gate = args.in[20]; side.w_up = args.in[21]; side.w_down = args.in[22]; side.wgu = wgu; side.wd = wd; side.scr = (LAS float*)(lds + RING_OFF + da::SHM_ATTN + 2048 + wave * 4608);
        side.item = bx * 8 + wave; side.item_end = NEXP * 1536; side.stride = G * 8; side.ph = 0; side.src = nullptr; side.dst = nullptr; side.N = 0; side.ldo = 0; side.mode = 0; side.r0 = da::f32x4s{}; side.r1 = da::f32x4s{};
        if (!(args.pad & 1)) for (int u = bx; u < 512; u += G) { const int bh = u & 7, qb = u >> 3, b = bh >> 2, h = bh & 3;
            da::attn_unit<0>(Q + ((size_t)b * S + qb * 128) * 512 + h * 128, Kb + (size_t)b * KV * 512 + h * 128, Vb + (size_t)b * KV * 512 + h * 128,
                          amix + ((size_t)b * S + qb * 128) * KO + h * 128, KO, KV, lds + RING_OFF, lds0, lam, gs, side); }
        while (side.item < side.item_end) { (void)da::side_step(side, lane); }
        asm volatile("s_waitcnt vmcnt(0) lgkmcnt(0)" ::: "memory"); __syncthreads();
        if (!(args.pad & 2)) for (int u = bx; u < 256; u += G) { const int b = u >> 7, g = (u >> 5) & 3, cq = u & 31;
            fft::fft_unit(F + (size_t)u * S * 4, amix + (size_t)b * S * KO + 512 + g * 256 + cq * 8, KO, (const bf16*)(ws + WS_F1T), (const float2*)(ws + WS_TW), (const bf16*)(ws + WS_F2P), lds + RING_OFF); }
    }
    SEAM(3);
    if (IN(4)) {
        pg8::Gemm g{amix, wout_t, M, D, KO}; pg8::StaticOrder S; S.init(M, D, G, bx);
        pg8::EpiOut E{args.in[0], modv, xl, ssq};
        pg8::gemm_phase<pg8::EpiOut, pg8::StaticOrder, true, true>(lds + RING_OFF, g, S, E);
    }
    SEAM(4);
    if (IN(5)) thin::p5_router(xl, ssq, args.in[7], modv, (const bf16*)(ws + WS_WRF), args.in[17], args.in[19], h2, cnt, tokof, expid, posb, gate, lds + RING_OFF, bx, G, tid, lane, wave);
    SEAM(5);
    if (IN(6) || IN(7) || IN(8)) {
        LAS int* tb = (LAS int*)(lds + TB_OFF); LAS int* toks = (LAS int*)(lds + TOKS_OFF);
        if (tid == 0) { int a = 0; for (int e = 0; e < NEXP; ++e) { tb[e] = a; a += ((int)cnt[e * 64] + 255) >> 8; } tb[NEXP] = a; }
        __syncthreads();
        pg8::MoeOrder S{tb[NEXP] * 4, G, bx, tb, toks};
        if (IN(6)) {
            for (int i = 0; i < 4; ++i) { pg8::Unit u; if (!S.next(i, u)) break;
                const int e = u.pn >> 2, pos = (u.pm - tb[e]) * 256 + tid;
                if (tid < 256) toks[i * 256 + tid] = pos < (int)cnt[e * 64] ? tokof[e * 16384 + pos] : 0; }
            __syncthreads();
            pg8::Gemm g{h2, wgu, MAXSLOT, 1024, D};
            pg8::EpiGateUp E{hmid};
            pg8::gemm_phase<pg8::EpiGateUp, pg8::MoeOrder, true, true, true>(lds + RING_OFF, g, S, E);
        }
        SEAM(6);
        if (IN(7)) {
            pg8::Gemm g{hmid, wd, MAXSLOT, 1024, DE};
            pg8::EpiDown E{ybuf};
            pg8::gemm_phase<pg8::EpiDown, pg8::MoeOrder, true, true, false>(lds + RING_OFF, g, S, E);
        }
        SEAM(7);
        if (IN(8)) thin::p8_final(ybuf, expid, posb, gate, modv, args.in[23], args.out, tb, bx, G, lane, wave);
    }
#undef IN
#undef SEAM
}


#if defined(ATT_PROBE)
__global__ void __launch_bounds__(NWAVES * 64, 2) probe_attn(Args args) {
    extern __shared__ __attribute__((aligned(16))) unsigned char lds_raw[];
    LAS unsigned char* lds = (LAS unsigned char*)lds_raw;
    const int tid = threadIdx.x, lane = tid & 63; const int G = gridDim.x, bx = blockIdx.x;
    unsigned char* ws = args.ws;
    bf16* amix = (bf16*)(ws + WS_AMIX); bf16* Q = (bf16*)(ws + WS_Q); bf16* Kb = (bf16*)(ws + WS_K); bf16* Vb = (bf16*)(ws + WS_V);
    for (int i = tid; i < RING_BYTES / 4; i += 512) ((LAS unsigned*)lds)[i] = 0u;
    __syncthreads();
    float gs[4] = {1.f, 1.f, 1.f, 1.f};
    const unsigned lds0 = (unsigned)(uintptr_t)lds_raw + RING_OFF;
    da::SideCvt side{}; side.item = 1; side.item_end = 0;
    for (int u = bx; u < 512; u += G) { const int bh = u & 7, qb = u >> 3, b = bh >> 2, h = bh & 3;
        da::attn_unit<ATT_PROBE>(Q + ((size_t)b * S + qb * 128) * 512 + h * 128, Kb + (size_t)b * KV * 512 + h * 128, Vb + (size_t)b * KV * 512 + h * 128,
                      amix + ((size_t)b * S + qb * 128) * KO + h * 128, KO, KV, lds + RING_OFF, lds0, 0.2f, gs, side); }
}
#endif
#define ONE_LAUNCH 1
#ifndef OPT_MASK
#define OPT_MASK 0x3FF
#endif
static void launch_phases(const Args& base, int lo, int hi, int li, int grid, hipStream_t stream, int flags = 0) {
    Args a = base; a.ph_lo = lo; a.ph_hi = hi; a.li = li; a.pad = flags;
    hipLaunchKernelGGL(mk_fwd, dim3(grid), dim3(NWAVES * 64), LDS_BYTES, stream, a);
    const hipError_t le = hipPeekAtLastError();
    if (le != hipSuccess) fprintf(stderr, "kernel_launch: mk_fwd [%d,%d) failed: %s\n", lo, hi, hipGetErrorName(le));
}
extern "C" void kernel_launch(void* const* d_in, const int* in_sizes, int n_in, void* d_out, int out_size, void* d_ws, size_t ws_size, hipStream_t stream) {
    static int ok = 0; static int grid_g = 256;
    if (ok == 0) {
        if (n_in != 24 || in_sizes[0] != M * D || out_size != M * D || ws_size < WS_END) { fprintf(stderr, "kernel_launch: shape/ws mismatch n_in %d in0 %d out %d ws %zu (need %zu)\n", n_in, n_in > 0 ? in_sizes[0] : -1, out_size, ws_size, (size_t)WS_END); ok = -1; return; }
        hipFuncSetAttribute((const void*)k_attn, hipFuncAttributeMaxDynamicSharedMemorySize, (2 * KV + 128 + 8 + 256) * 4);
        hipFuncSetAttribute((const void*)k_fft, hipFuncAttributeMaxDynamicSharedMemorySize, 2 * 8192 * 4 + S * 4 * 2);
        if (hipFuncSetAttribute((const void*)mk_fwd, hipFuncAttributeMaxDynamicSharedMemorySize, LDS_BYTES) != hipSuccess) { fprintf(stderr, "kernel_launch: hipFuncSetAttribute(mk_fwd) failed\n"); ok = -1; return; }
        int dev = 0, cus = 0, per_cu = 0;
        hipGetDevice(&dev); hipDeviceGetAttribute(&cus, hipDeviceAttributeMultiprocessorCount, dev);
        hipOccupancyMaxActiveBlocksPerMultiprocessor(&per_cu, (const void*)mk_fwd, NWAVES * 64, LDS_BYTES);
        if (per_cu < 1 || cus != 256) fprintf(stderr, "kernel_launch: note: occupancy %d blocks/CU, %d CUs\n", per_cu, cus);
        (void)hipGetLastError();
        grid_g = cus;
        ok = 1;
    }
    if (ok < 0) return;
    const float* x = (const float*)d_in[0]; const float* c = (const float*)d_in[1]; const float* ctx = (const float*)d_in[2]; const float* cctx = (const float*)d_in[3];
    const float* w_ada = (const float*)d_in[4]; const float* b_ada = (const float*)d_in[5]; const float* gmix = (const float*)d_in[6]; const float* gffn = (const float*)d_in[7];
    const float* w_in = (const float*)d_in[8]; const float* lq1 = (const float*)d_in[9]; const float* lk1 = (const float*)d_in[10]; const float* lq2 = (const float*)d_in[11]; const float* lk2 = (const float*)d_in[12];
    const float* gsub = (const float*)d_in[13]; const float* wfour = (const float*)d_in[14]; const float* w_out = (const float*)d_in[15];
    const float* wrg = (const float*)d_in[16]; const float* brg = (const float*)d_in[17]; const float* wre = (const float*)d_in[18]; const float* bre = (const float*)d_in[19];
    const float* w_gate = (const float*)d_in[20]; const float* w_up = (const float*)d_in[21]; const float* w_down = (const float*)d_in[22]; const float* gfin = (const float*)d_in[23];
    unsigned char* ws = (unsigned char*)d_ws; float* out = (float*)d_out;
    unsigned* ctl = (unsigned*)(ws + WS_CTL); float* modv = (float*)(ws + WS_MOD); float* rope = (float*)(ws + WS_ROPE); float* cs = (float*)(ws + WS_CS);
    int* expid = (int*)(ws + WS_RT); int* posb = expid + M * 2; float* gate = (float*)(posb + M * 2);
    int* tokof = (int*)(ws + WS_TOKOF);
    bf16* win_t = (bf16*)(ws + WS_WIN_T); bf16* wout_t = (bf16*)(ws + WS_WOUT_T); bf16* wgu = (bf16*)(ws + WS_WGU); bf16* wd = (bf16*)(ws + WS_WD);
    bf16* hl = (bf16*)(ws + WS_HL); bf16* hc = (bf16*)(ws + WS_HC); bf16* amix = (bf16*)(ws + WS_AMIX); bf16* ybuf = (bf16*)(ws + WS_YBUF);
    bf16* Q = (bf16*)(ws + WS_Q); bf16* Kb = (bf16*)(ws + WS_K); bf16* Vb = (bf16*)(ws + WS_V); bf16* F = (bf16*)(ws + WS_F);
    bf16* h2 = (bf16*)(ws + WS_H2); bf16* hmid = (bf16*)(ws + WS_HMID);
    float* xl = out;
    Args base{}; for (int i = 0; i < 24; ++i) base.in[i] = (const float*)d_in[i]; base.out = out; base.ws = ws;
    hipMemsetAsync(ws + WS_CTL, 0, CTL_ZERO_BYTES, stream);
#if defined(ONE_LAUNCH)
    launch_phases(base, 0, 9, 0, grid_g, stream);
#if defined(ATT_PROBE)
    { Args a = base; a.ph_lo = 0; a.ph_hi = 0; a.li = 1; a.pad = 0; hipFuncSetAttribute((const void*)probe_attn, hipFuncAttributeMaxDynamicSharedMemorySize, LDS_BYTES); hipLaunchKernelGGL(probe_attn, dim3(grid_g), dim3(NWAVES * 64), LDS_BYTES, stream, a); }
#endif
#else
    if (OPT_MASK & 1) launch_phases(base, 0, 1, 0, grid_g, stream);
    else {
    k_mod<<<dim3(6144 / 256, 3), 256, 0, stream>>>(c, cctx, w_ada, b_ada, modv);
    k_tables<<<8, 256, 0, stream>>>(rope);
    k_fft_tables<<<128, 256, 0, stream>>>((bf16*)(ws + WS_F1T), (float2*)(ws + WS_TW), (bf16*)(ws + WS_F2P));
    k_cvtT<<<dim3(D * 2048 / 256, 1), 256, 0, stream>>>(w_in, D, 2048, 0, win_t, D, 0, 0, 0);
    k_cvtT<<<dim3(512 * D / 256, 1), 256, 0, stream>>>(w_out, 512, D, 0, wout_t, KO, 0, 0, 0);
    k_cvtT<<<dim3(D * DE / 256, NEXP), 256, 0, stream>>>(w_gate, D, DE, (size_t)D * DE, wgu, D, 0, (size_t)1024 * D, 1);
    k_cvtT<<<dim3(D * DE / 256, NEXP), 256, 0, stream>>>(w_up, D, DE, (size_t)D * DE, wgu, D, 0, (size_t)1024 * D, 2);
    k_cvtT<<<dim3(DE * D / 256, NEXP), 256, 0, stream>>>(w_down, DE, D, (size_t)DE * D, wd, DE, 0, (size_t)1024 * DE, 0);
    k_fold1<<<4 * 2 * 128 * 128 / 256, 256, 0, stream>>>(wfour, cs);
    }
    if (OPT_MASK & 2) launch_phases(base, 1, 2, 0, grid_g, stream);
    else { k_fold2<<<dim3(D / 256, 1024), 256, 0, stream>>>(cs, w_out, wout_t); k_normmod<<<M + 512, 256, 0, stream>>>(x, ctx, gmix, modv, hl); }
    if (OPT_MASK & 4) launch_phases(base, 2, 3, 0, grid_g, stream);
    else { PInProj p{hl, win_t, rope, Q, Kb, Vb, F, D}; k_gemm<PInProj><<<dim3(2048 / 64, M / 64), 256, 0, stream>>>(p);
           PCtx p2{hc, win_t, Kb, Vb, D}; k_gemm<PCtx><<<dim3(1024 / 64, 512 / 64), 256, 0, stream>>>(p2); }
    if ((OPT_MASK & 8) || (OPT_MASK & 0x200)) launch_phases(base, 3, 4, 0, grid_g, stream, ((OPT_MASK & 8) ? 0 : 1) | ((OPT_MASK & 0x200) ? 0 : 2));
    if (!(OPT_MASK & 8)) k_attn<<<dim3(M, NH), 256, (2 * KV + 128 + 8 + 256) * 4, stream>>>(Q, Kb, Vb, amix, lq1, lk1, lq2, lk2, gsub);
    if (!(OPT_MASK & 0x200)) k_fft<<<dim3(128, 256), 256, 2 * 8192 * 4 + S * 4 * 2, stream>>>(F, amix);
    if (OPT_MASK & 16) launch_phases(base, 4, 5, 0, grid_g, stream);
    else { POut p{amix, wout_t, x, modv, xl, KO}; k_gemm<POut><<<dim3(D / 64, M / 64), 256, 0, stream>>>(p); }
    if (OPT_MASK & 32) launch_phases(base, 5, 6, 0, grid_g, stream);
    else k_router<<<M, 256, 0, stream>>>(xl, gffn, modv, wrg, brg, wre, bre, h2, ctl + CW_CNT, tokof, expid, posb, gate, (OPT_MASK & 16) ? (const float*)(ws + WS_SSQ) : nullptr);
    if (OPT_MASK & 64) launch_phases(base, 6, 7, 0, grid_g, stream);
    else { PGateUp p{h2, wgu, ctl + CW_CNT, tokof, hmid, D, 0, 0, 0}; k_gemm<PGateUp><<<dim3(1024 / 64, 256, NEXP), 256, 0, stream>>>(p); }
    if (OPT_MASK & 128) launch_phases(base, 7, 8, 0, grid_g, stream);
    else { PDown p{hmid, wd, ctl + CW_CNT, ybuf, DE, 0, 0, 0}; k_gemm<PDown><<<dim3(1024 / 64, 256, NEXP), 256, 0, stream>>>(p); }
    if (OPT_MASK & 256) launch_phases(base, 8, 9, 0, grid_g, stream);
    else k_final<<<M, 256, 0, stream>>>(xl, ybuf, ctl + CW_CNT, expid, posb, gate, modv, gfin, out);
#endif
}
```
